# Optimizing an MI355X kernel written in HIP

```python
import math
import jax, jax.numpy as jnp
from jax import lax
import numpy as np

D_MODEL = 1024
BATCH = 1
SEQ = 16384
DEPTH = 2

N_EVEN = (DEPTH + 1) // 2
N_ODD = DEPTH // 2
EPS = 1e-6

GM_HEADS = 4
GM_WIDTH = D_MODEL
GM_HEAD_DIM = GM_WIDTH // GM_HEADS
GM_CHUNK = 128

SSM_WIDTH = D_MODEL
SSM_HEAD_DIM = 64
SSM_HEADS = SSM_WIDTH // SSM_HEAD_DIM
SSM_GROUPS = 4
SSM_HEADS_PER_GROUP = SSM_HEADS // SSM_GROUPS
SSM_STATE = 128
SSM_CONV = 4
SSM_CHUNK = 128
SSM_CONV_DIM = SSM_WIDTH + 2 * SSM_GROUPS * SSM_STATE
DT_MIN = 0.001
DT_MAX = 0.1
DT_FLOOR = 1e-4

IN_PROJ_DIM = 2 * GM_WIDTH + SSM_WIDTH + SSM_CONV_DIM + SSM_HEADS
SPLIT_POINTS = (GM_WIDTH, 2 * GM_WIDTH, 2 * GM_WIDTH + SSM_WIDTH, 2 * GM_WIDTH + SSM_WIDTH + SSM_CONV_DIM)
MIX_WIDTH = GM_WIDTH + SSM_WIDTH

POOL_WINDOWS = (2, 4, 8, 16)
POOL_GROUPS = len(POOL_WINDOWS)
POOL_GROUP_DIM = D_MODEL // POOL_GROUPS

D_FF = ((8 * D_MODEL // 3 + 255) // 256) * 256

kernel_name = "hybrid_gmlp_ssd_pool_decoder"


def rms_norm(x, g):
    xf = x.astype(jnp.float32)
    y = xf * lax.rsqrt(jnp.mean(xf * xf, axis=-1, keepdims=True) + EPS)
    return (y * g.astype(jnp.float32)).astype(x.dtype)


def layer_norm(x, g, b):
    xf = x.astype(jnp.float32)
    mu = jnp.mean(xf, axis=-1, keepdims=True)
    xc = xf - mu
    y = xc * lax.rsqrt(jnp.mean(xc * xc, axis=-1, keepdims=True) + EPS)
    return (y * g.astype(jnp.float32) + b.astype(jnp.float32)).astype(x.dtype)


def gmlp_spatial_gating(u, v, ln_g, ln_b, w_s, b_s):
    bsz, seqlen, _ = v.shape
    n_chunks = seqlen // GM_CHUNK
    v = layer_norm(v, ln_g, ln_b).reshape(bsz, n_chunks, GM_CHUNK, GM_HEADS, GM_HEAD_DIM)
    causal = jnp.tril(jnp.ones((GM_CHUNK, GM_CHUNK), dtype=bool))
    w = jnp.where(causal[None], w_s, 0).astype(v.dtype)
    mixed = jnp.einsum("hts,bcshd->bcthd", w, v) + b_s.T.astype(v.dtype)[None, None, :, :, None]
    return u * mixed.reshape(bsz, seqlen, GM_WIDTH)


def causal_depthwise_conv(x, w, b):
    channels = x.shape[-1]
    y = lax.conv_general_dilated(
        x, w[:, None, :].astype(x.dtype), window_strides=(1,), padding=[(SSM_CONV - 1, 0)],
        dimension_numbers=("NWC", "WIO", "NWC"), feature_group_count=channels)
    return y + b.astype(x.dtype)


def segsum_exp(a_cum):
    n = a_cum.shape[-1]
    diff = a_cum[..., :, None] - a_cum[..., None, :]
    mask = jnp.tril(jnp.ones((n, n), dtype=bool))
    return jnp.exp(jnp.where(mask, diff, -jnp.inf))


def ssd_chunked(x, dt, a, b_mat, c_mat):
    bsz, seqlen = x.shape[:2]
    nc = seqlen // SSM_CHUNK

    def chunk(t):
        return t.reshape((bsz, nc, SSM_CHUNK) + t.shape[2:])

    xdt = chunk(x * dt[..., None])
    a_cum = jnp.cumsum(jnp.moveaxis(chunk(dt * a), 2, -1), axis=-1)
    b_c, c_c = chunk(b_mat), chunk(c_mat)
    decay = segsum_exp(a_cum)
    cb = jnp.einsum("bclgn,bcsgn->bcgls", c_c, b_c)
    y_diag = jnp.einsum("bcgls,bcgrls,bcsgrp->bclgrp", cb, decay, xdt)
    decay_to_end = jnp.exp(a_cum[..., -1:] - a_cum)
    chunk_states = jnp.einsum("bclgn,bcgrl,bclgrp->bcgrpn", b_c, decay_to_end, xdt)
    chunk_decay = jnp.exp(a_cum[..., -1])

    def step(state, inp):
        dec, new = inp
        return state * dec[..., None, None] + new, state

    init = jnp.zeros_like(chunk_states[:, 0])
    _, prev_states = lax.scan(step, init, (jnp.moveaxis(chunk_decay, 1, 0), jnp.moveaxis(chunk_states, 1, 0)))
    prev_states = jnp.moveaxis(prev_states, 0, 1)
    y_off = jnp.einsum("bclgn,bcgrpn,bcgrl->bclgrp", c_c, prev_states, jnp.exp(a_cum))
    return (y_diag + y_off).reshape((bsz, seqlen) + x.shape[2:])


def hybrid_gmlp_ssd_mixer(h, w_in, gm_ln_g, gm_ln_b, gm_ws, gm_bs, conv_w, conv_b,
                          dt_bias, a_log, d_skip, ssm_norm_g, w_out):
    f32 = jnp.float32
    bsz, seqlen, _ = h.shape
    proj = h @ w_in
    u, v, z, xbc, dt_raw = jnp.split(proj, SPLIT_POINTS, axis=-1)
    y_a = gmlp_spatial_gating(jax.nn.gelu(u), jax.nn.gelu(v), gm_ln_g, gm_ln_b, gm_ws, gm_bs)
    xbc = jax.nn.silu(causal_depthwise_conv(xbc, conv_w, conv_b))
    xs, b_mat, c_mat = jnp.split(xbc, (SSM_WIDTH, SSM_WIDTH + SSM_GROUPS * SSM_STATE), axis=-1)
    dt = jax.nn.softplus(dt_raw.astype(f32) + dt_bias.astype(f32))
    a = -jnp.exp(a_log.astype(f32))
    xs_h = xs.astype(f32).reshape(bsz, seqlen, SSM_GROUPS, SSM_HEADS_PER_GROUP, SSM_HEAD_DIM)
    y = ssd_chunked(
        xs_h,
        dt.reshape(bsz, seqlen, SSM_GROUPS, SSM_HEADS_PER_GROUP),
        a.reshape(SSM_GROUPS, SSM_HEADS_PER_GROUP),
        b_mat.astype(f32).reshape(bsz, seqlen, SSM_GROUPS, SSM_STATE),
        c_mat.astype(f32).reshape(bsz, seqlen, SSM_GROUPS, SSM_STATE))
    y = y + d_skip.astype(f32).reshape(SSM_GROUPS, SSM_HEADS_PER_GROUP)[:, :, None] * xs_h
    gated = (y.reshape(bsz, seqlen, SSM_WIDTH) * jax.nn.silu(z.astype(f32)))
    gated = gated.reshape(bsz, seqlen, SSM_GROUPS, SSM_WIDTH // SSM_GROUPS)
    gated = gated * lax.rsqrt(jnp.mean(gated * gated, axis=-1, keepdims=True) + EPS)
    y_b = (gated.reshape(bsz, seqlen, SSM_WIDTH) * ssm_norm_g.astype(f32)).astype(h.dtype)
    return jnp.concatenate([y_a, y_b], axis=-1) @ w_out


def multiscale_pool_mixer(h, pool_w, pool_b, pool_scale):
    f32 = jnp.float32
    bsz, seqlen, _ = h.shape
    hf = h.astype(f32).reshape(bsz, seqlen, POOL_GROUPS, POOL_GROUP_DIM)
    cs = jnp.cumsum(hf, axis=1)
    cs = jnp.concatenate([jnp.zeros_like(cs[:, :1]), cs], axis=1)
    pos = jnp.arange(1, seqlen + 1, dtype=f32)
    pooled = []
    for g, win in enumerate(POOL_WINDOWS):
        cs_g = cs[:, :, g]
        upper = cs_g[:, 1:]
        lower = jnp.pad(cs_g, ((0, 0), (win - 1, 0), (0, 0)))[:, :seqlen]
        count = jnp.minimum(pos, float(win))[None, :, None]
        pooled.append((upper - lower) / count)
    pooled = jnp.stack(pooled, axis=2)
    out = jnp.einsum("blgc,gcd->blgd", pooled - hf, pool_w.astype(f32)) + pool_b.astype(f32)
    return (out.reshape(bsz, seqlen, D_MODEL) * pool_scale.astype(f32)).astype(h.dtype)


def swiglu(h, w_gate, w_up, w_down):
    return (jax.nn.silu(h @ w_gate) * (h @ w_up)) @ w_down


def setup_inputs(seed: int = 0) -> dict:
    key = jax.random.key(seed)
    ks = jax.random.split(key, 20)
    f32 = jnp.float32

    def nrm(k, shape, scale):
        return jax.random.normal(k, shape, f32) * scale

    x = nrm(ks[0], (BATCH, SEQ, D_MODEL), 1.0)
    norm_g = 1.0 + nrm(ks[1], (DEPTH, 4, D_MODEL), 0.02)
    w_in = nrm(ks[2], (N_EVEN, D_MODEL, IN_PROJ_DIM), D_MODEL ** -0.5)
    gm_ln_g = 1.0 + nrm(ks[3], (N_EVEN, GM_WIDTH), 0.02)
    gm_ln_b = nrm(ks[4], (N_EVEN, GM_WIDTH), 0.02)
    gm_ws = nrm(ks[5], (N_EVEN, GM_HEADS, GM_CHUNK, GM_CHUNK), GM_CHUNK ** -0.5)
    gm_bs = 1.0 + nrm(ks[6], (N_EVEN, GM_HEADS, GM_CHUNK), 0.02)
    conv_w = nrm(ks[7], (N_EVEN, SSM_CONV, SSM_CONV_DIM), SSM_CONV ** -0.5)
    conv_b = nrm(ks[8], (N_EVEN, SSM_CONV_DIM), 0.02)
    dt0 = jnp.exp(jax.random.uniform(ks[9], (N_EVEN, SSM_HEADS), f32, math.log(DT_MIN), math.log(DT_MAX)))
    dt0 = jnp.maximum(dt0, DT_FLOOR)
    dt_bias = dt0 + jnp.log(-jnp.expm1(-dt0))
    a_log = jnp.log(jax.random.uniform(ks[10], (N_EVEN, SSM_HEADS), f32, 1.0, 16.0))
    d_skip = 1.0 + nrm(ks[11], (N_EVEN, SSM_HEADS), 0.02)
    ssm_norm_g = 1.0 + nrm(ks[12], (N_EVEN, SSM_WIDTH), 0.02)
    w_out = nrm(ks[13], (N_EVEN, MIX_WIDTH, D_MODEL), MIX_WIDTH ** -0.5)
    pool_w = nrm(ks[14], (N_ODD, POOL_GROUPS, POOL_GROUP_DIM, POOL_GROUP_DIM), POOL_GROUP_DIM ** -0.5)
    pool_b = nrm(ks[15], (N_ODD, POOL_GROUPS, POOL_GROUP_DIM), 0.02)
    pool_scale = 1.0 + nrm(ks[16], (N_ODD, D_MODEL), 0.1)
    ffn_w_gate = nrm(ks[17], (DEPTH, D_MODEL, D_FF), D_MODEL ** -0.5)
    ffn_w_up = nrm(ks[18], (DEPTH, D_MODEL, D_FF), D_MODEL ** -0.5)
    ffn_w_down = nrm(ks[19], (DEPTH, D_FF, D_MODEL), D_FF ** -0.5)
    return {"x": x, "norm_g": norm_g, "w_in": w_in, "gm_ln_g": gm_ln_g, "gm_ln_b": gm_ln_b,
            "gm_ws": gm_ws, "gm_bs": gm_bs, "conv_w": conv_w, "conv_b": conv_b,
            "dt_bias": dt_bias, "a_log": a_log, "d_skip": d_skip, "ssm_norm_g": ssm_norm_g,
            "w_out": w_out, "pool_w": pool_w, "pool_b": pool_b, "pool_scale": pool_scale,
            "ffn_w_gate": ffn_w_gate, "ffn_w_up": ffn_w_up, "ffn_w_down": ffn_w_down}


def reference(x, norm_g, w_in, gm_ln_g, gm_ln_b, gm_ws, gm_bs, conv_w, conv_b, dt_bias, a_log,
              d_skip, ssm_norm_g, w_out, pool_w, pool_b, pool_scale, ffn_w_gate, ffn_w_up, ffn_w_down):
    h = x
    for layer in range(DEPTH):
        i = layer // 2
        y = rms_norm(h, norm_g[layer, 0])
        if layer % 2 == 0:
            y = hybrid_gmlp_ssd_mixer(y, w_in[i], gm_ln_g[i], gm_ln_b[i], gm_ws[i], gm_bs[i],
                                      conv_w[i], conv_b[i], dt_bias[i], a_log[i], d_skip[i],
                                      ssm_norm_g[i], w_out[i])
        else:
            y = multiscale_pool_mixer(y, pool_w[i], pool_b[i], pool_scale[i])
        h = h + rms_norm(y, norm_g[layer, 1])
        y = swiglu(rms_norm(h, norm_g[layer, 2]), ffn_w_gate[layer], ffn_w_up[layer], ffn_w_down[layer])
        h = h + rms_norm(y, norm_g[layer, 3])
    return h
```

```cpp
#include <hip/hip_runtime.h>
#include <hip/hip_cooperative_groups.h>
#include <cstdio>
#include <cstdint>
namespace cg = cooperative_groups;

#define LAS __attribute__((address_space(3)))
typedef unsigned short bf16_t;
typedef short bf16x8 __attribute__((ext_vector_type(8)));
typedef short s16x4 __attribute__((ext_vector_type(4)));
typedef float f32x4 __attribute__((ext_vector_type(4)));
typedef float f32x2 __attribute__((ext_vector_type(2)));
typedef unsigned u32x4 __attribute__((ext_vector_type(4)));
typedef unsigned u32x2 __attribute__((ext_vector_type(2)));

#ifndef ONE_LAUNCH
#define ONE_LAUNCH 1
#endif

constexpr int M = 16384, D = 1024, DFF = 2816, LDPROJ = 5120, WIN_LD = 5136, NCHUNK = 128;
constexpr float EPS = 1e-6f;
constexpr int NPHASE = 16;
constexpr int COL_U = 0, COL_Z = 1024, COL_V = 2048, COL_XBC = 3072;
constexpr size_t MiB = 1u << 20;
constexpr size_t WS_WIN = 1 * MiB, WS_WOUT = 11 * MiB, WS_WGU = 15 * MiB, WS_WDN = 37 * MiB, WS_WPOOL = 48 * MiB, WS_DT = 49 * MiB, WS_CD = 50 * MiB,
                 WS_R1 = 51 * MiB, WS_PROJ = 83 * MiB, WS_END = 243 * MiB;
constexpr int LDS_BYTES = 147456;

typedef __bf16 bf16x2_t __attribute__((ext_vector_type(2)));
__device__ __forceinline__ unsigned pk2(float lo, float hi) { const f32x2 f = {lo, hi}; const bf16x2_t v = __builtin_convertvector(f, bf16x2_t); return __builtin_bit_cast(unsigned, v); }
__device__ __forceinline__ float bflo(unsigned w) { return __uint_as_float(w << 16); }
__device__ __forceinline__ float bfhi(unsigned w) { return __uint_as_float(w & 0xffff0000u); }
__device__ __forceinline__ float fsilu(float x) { return x * __builtin_amdgcn_rcpf(1.f + __builtin_amdgcn_exp2f(-1.4426950409f * x)); }
__device__ __forceinline__ float gelu_tanh(float x) { const float z = 1.5957691216f * (x + 0.044715f * x * x * x); return x * __builtin_amdgcn_rcpf(1.f + __builtin_amdgcn_exp2f(-1.4426950409f * z)); }
__device__ __forceinline__ float wave_sum(float v) {
#pragma unroll
    for (int o = 1; o < 64; o <<= 1) v += __shfl_xor(v, o);
    return v;
}
#define MFMA16(a, b, c) __builtin_amdgcn_mfma_f32_16x16x32_bf16((a), (b), (c), 0, 0, 0)

namespace pg8 {
constexpr int BM = 256, BK = 64, HALF = 128, HTB = HALF * BK * 2, STAGE_BYTES = 8 * HTB, NXCD = 8, WGM = 8;
__host__ __device__ __forceinline__ int lds_byte(int r, int c) { const int st = (r >> 4) * 2 + (c >> 5), rr = r & 15, cc = c & 31, ob = rr * 64 + cc * 2; return st * 1024 + (ob ^ (((ob >> 9) & 1) << 5)); }
__host__ __device__ __forceinline__ void stage_rc(int b, int& R, int& C) { const int st = b / 1024, sb = b % 1024, swz = sb ^ (((sb >> 9) & 1) << 5); R = (st >> 1) * 16 + swz / 64; C = (st & 1) * 32 + (swz % 64) / 2; }
__host__ __device__ __forceinline__ int perm32(int rho) { const int n = rho >> 4, i = rho & 15; return 8 * (i >> 2) + 4 * n + (i & 3); }

struct Unit { int pm, pn; };
struct Gemm { const bf16_t* A; const bf16_t* Bt; int M, N, K, lda, ldb, a_col_step  ; };

struct StaticOrder {
    int nM, nN, nwg, G, c;
    __device__ void init(int M_, int N_, int G_, int c_) { nM = M_ / BM; nN = N_ / BM; nwg = nM * nN; G = G_; c = c_; }
    __device__ bool next(int i, Unit& u) const {
        const long L = (long)i * G + c; if (L >= nwg) return false;
        int wgid = (int)L; { const int q = nwg / NXCD, r = nwg % NXCD, xcd = wgid % NXCD, off = wgid / NXCD; wgid = (xcd < r ? xcd * (q + 1) : r * (q + 1) + (xcd - r) * q) + off; }
        const int nig = WGM * nN, gid = wgid / nig, fm = gid * WGM, gsz = (nM - fm) < WGM ? (nM - fm) : WGM;
        u.pm = fm + ((wgid % nig) % gsz); u.pn = (wgid % nig) / gsz; return true;
    }
};

struct EpiProj {
    bf16_t* O; int ldc;
    __device__ __forceinline__ void operator()(const f32x4 (&acc)[2][2][4][2], const Unit& u, int wr, int wc, int fr, int fq) const {
        const bool act = (u.pn < 4) || (u.pn >= 8 && u.pn < 12);
        const int row0 = u.pm * BM + wr * 64 + fr, col0 = u.pn * BM + wc * 32 + 8 * fq;
#pragma unroll
        for (int ai = 0; ai < 2; ++ai)
#pragma unroll
            for (int m = 0; m < 4; ++m) { bf16_t* rowp = O + (size_t)(row0 + ai * HALF + m * 16) * ldc + col0;
#pragma unroll
                for (int bj = 0; bj < 2; ++bj) { f32x4 v0 = acc[ai][bj][m][0], v1 = acc[ai][bj][m][1];
                    if (act) {
#pragma unroll
                        for (int e = 0; e < 4; ++e) { v0[e] = gelu_tanh(v0[e]); v1[e] = gelu_tanh(v1[e]); } }
                    u32x4 w; w.x = pk2(v0[0], v0[1]); w.y = pk2(v0[2], v0[3]); w.z = pk2(v1[0], v1[1]); w.w = pk2(v1[2], v1[3]);
                    *(u32x4*)(rowp + bj * HALF) = w; } }
    }
};
struct EpiSwiGLU {
    bf16_t* O; int ldc;
    __device__ __forceinline__ void operator()(const f32x4 (&acc)[2][2][4][2], const Unit& u, int wr, int wc, int fr, int fq) const {
        const int row0 = u.pm * BM + wr * 64 + fr, col0 = u.pn * HALF + wc * 32 + 8 * fq;
#pragma unroll
        for (int ai = 0; ai < 2; ++ai)
#pragma unroll
            for (int m = 0; m < 4; ++m) { bf16_t* rowp = O + (size_t)(row0 + ai * HALF + m * 16) * ldc + col0;
                f32x4 h0, h1;
#pragma unroll
                for (int e = 0; e < 4; ++e) { h0[e] = fsilu(acc[ai][0][m][0][e]) * acc[ai][1][m][0][e]; h1[e] = fsilu(acc[ai][0][m][1][e]) * acc[ai][1][m][1][e]; }
                u32x4 w; w.x = pk2(h0[0], h0[1]); w.y = pk2(h0[2], h0[3]); w.z = pk2(h1[0], h1[1]); w.w = pk2(h1[2], h1[3]);
                *(u32x4*)rowp = w; }
    }
};
struct EpiY {
    bf16_t* O; int ldc; const float* bias; const float* scale;
    __device__ __forceinline__ void operator()(const f32x4 (&acc)[2][2][4][2], const Unit& u, int wr, int wc, int fr, int fq) const {
        const int row0 = u.pm * BM + wr * 64 + fr, col0 = u.pn * BM + wc * 32 + 8 * fq;
        f32x4 bv[2][2], sv[2][2];
#pragma unroll
        for (int bj = 0; bj < 2; ++bj)
#pragma unroll
            for (int n = 0; n < 2; ++n) { bv[bj][n] = bias ? *(const f32x4*)(bias + col0 + bj * HALF + 4 * n) : (f32x4){0.f, 0.f, 0.f, 0.f};
                                          sv[bj][n] = scale ? *(const f32x4*)(scale + col0 + bj * HALF + 4 * n) : (f32x4){1.f, 1.f, 1.f, 1.f}; }
#pragma unroll
        for (int ai = 0; ai < 2; ++ai)
#pragma unroll
            for (int m = 0; m < 4; ++m) { bf16_t* rowp = O + (size_t)(row0 + ai * HALF + m * 16) * ldc + col0;
#pragma unroll
                for (int bj = 0; bj < 2; ++bj) { const f32x4 v0 = (acc[ai][bj][m][0] + bv[bj][0]) * sv[bj][0], v1 = (acc[ai][bj][m][1] + bv[bj][1]) * sv[bj][1];
                    u32x4 w; w.x = pk2(v0[0], v0[1]); w.y = pk2(v0[2], v0[3]); w.z = pk2(v1[0], v1[1]); w.w = pk2(v1[2], v1[3]);
                    *(u32x4*)(rowp + bj * HALF) = w; } }
    }
};

template <class Epi>
__device__ __forceinline__ void gemm_phase(LAS unsigned char* lds, const Gemm g, const StaticOrder& S, const Epi& E) {
    const int tid = threadIdx.x, wid = __builtin_amdgcn_readfirstlane(tid >> 6), lane = tid & 63, wr = wid >> 2, wc = wid & 3, fr = lane & 15, fq = lane >> 4;
    const int K = g.K, nt = K / BK;
    unsigned voffA[2], voffB[2];
#pragma unroll
    for (int i = 0; i < 2; ++i) { int R, C; stage_rc(tid * 16 + i * 8192, R, C); const int Rb = (R & ~31) + perm32(R & 31);
        voffA[i] = (unsigned)(R * g.lda + C) * 2u; voffB[i] = (unsigned)(Rb * g.ldb + C) * 2u; }
    const size_t kstep = (size_t)(BK * 2);
    const size_t hstepA = (size_t)HALF * g.lda * 2, hstepB = (size_t)HALF * g.ldb * 2;
    const size_t tstepA = 2 * hstepA, tstepB = 2 * hstepB;
    const unsigned ldsw = (unsigned)wid * 1024u;
    const int aoff = lds_byte(wr * 64 + fr, fq * 8), boff = lds_byte(wc * 32 + fr, fq * 8);
#define PG8_SA(b, h) (((b) * 2 + (h)) * HTB)
#define PG8_SB(b, h) ((4 + (b) * 2 + (h)) * HTB)
#define PG8_STAGE(bufoff, gbase, voff) do { _Pragma("unroll") for (int _i = 0; _i < 2; ++_i) \
        __builtin_amdgcn_global_load_lds((const unsigned*)((const char*)(gbase) + (voff)[_i]), (LAS unsigned*)(lds + (bufoff) + ldsw + _i * 8192), 16, 0, 0); } while (0)
#define PG8_LDA(dst, b, h) do { _Pragma("unroll") for (int m = 0; m < 4; ++m) _Pragma("unroll") for (int k = 0; k < 2; ++k) dst[m][k] = *(const LAS bf16x8*)(lds + PG8_SA(b, h) + aoff + m * 2048 + k * 1024); } while (0)
#define PG8_LDB(dst, b, h) do { _Pragma("unroll") for (int n = 0; n < 2; ++n) _Pragma("unroll") for (int k = 0; k < 2; ++k) dst[n][k] = *(const LAS bf16x8*)(lds + PG8_SB(b, h) + boff + n * 2048 + k * 1024); } while (0)
#define PG8_MMA(ai, bj, At, Bt) do { __builtin_amdgcn_s_setprio(1); _Pragma("unroll") for (int m = 0; m < 4; ++m) _Pragma("unroll") for (int n = 0; n < 2; ++n) _Pragma("unroll") for (int k = 0; k < 2; ++k) \
        acc[ai][bj][m][n] = __builtin_amdgcn_mfma_f32_16x16x32_bf16(Bt[n][k], At[m][k], acc[ai][bj][m][n], 0, 0, 0); __builtin_amdgcn_s_setprio(0); } while (0)
#define PG8_WAIT_V(n) asm volatile("s_waitcnt vmcnt(" #n ")" ::: "memory")
#define PG8_WAIT_L(n) asm volatile("s_waitcnt lgkmcnt(" #n ")" ::: "memory")
#define PG8_BAR __builtin_amdgcn_s_barrier()
#define PG8_SCHED __builtin_amdgcn_sched_barrier(0)
    Unit cur, nxt; int ui = 0;
    if (!S.next(0, cur)) return;
    f32x4 acc[2][2][4][2];
#pragma unroll
    for (int a = 0; a < 2; ++a)
#pragma unroll
        for (int b = 0; b < 2; ++b)
#pragma unroll
            for (int m = 0; m < 4; ++m)
#pragma unroll
                for (int n = 0; n < 2; ++n) acc[a][b][m][n] = (f32x4){0.f, 0.f, 0.f, 0.f};
    bf16x8 At[4][2], B0[2][2], B1[2][2];
    const char* cA = (const char*)g.A + (size_t)cur.pm * tstepA + (size_t)cur.pn * g.a_col_step; const char* cB = (const char*)g.Bt + (size_t)cur.pn * tstepB;
    PG8_STAGE(PG8_SB(0, 0), cB, voffB); PG8_STAGE(PG8_SB(0, 1), cB + hstepB, voffB); PG8_STAGE(PG8_SA(0, 0), cA, voffA); PG8_STAGE(PG8_SA(0, 1), cA + hstepA, voffA);
    if (wr == 1) PG8_BAR;
    PG8_WAIT_V(2); PG8_BAR;
    PG8_STAGE(PG8_SB(1, 0), cB + kstep, voffB); PG8_STAGE(PG8_SA(1, 0), cA + kstep, voffA); PG8_STAGE(PG8_SB(1, 1), cB + hstepB + kstep, voffB);
    PG8_WAIT_V(6); PG8_BAR;
    for (;;) {
        const bool has_next = S.next(ui + 1, nxt);
        const char* nA = has_next ? (const char*)g.A + (size_t)nxt.pm * tstepA + (size_t)nxt.pn * g.a_col_step : cA; const char* nB = has_next ? (const char*)g.Bt + (size_t)nxt.pn * tstepB : cB;
        for (int t = 0; t < nt; t += 2) {
            const bool last = (t == nt - 2);
            const char* a1 = cA + (size_t)(t + 1) * kstep;
            const char* a2 = last ? nA : cA + (size_t)(t + 2) * kstep; const char* b2 = last ? nB : cB + (size_t)(t + 2) * kstep;
            const char* a3 = a2 + kstep; const char* b3 = b2 + kstep;
            PG8_LDB(B0, 0, 0); PG8_LDB(B1, 0, 1); PG8_SCHED; PG8_LDA(At, 0, 0); PG8_STAGE(PG8_SA(1, 1), a1 + hstepA, voffA);
            PG8_WAIT_V(8); PG8_WAIT_L(0); PG8_BAR; PG8_MMA(0, 0, At, B0); PG8_MMA(0, 1, At, B1); PG8_BAR; PG8_SCHED;
            PG8_LDA(At, 0, 1); PG8_STAGE(PG8_SB(0, 0), b2, voffB); PG8_STAGE(PG8_SB(0, 1), b2 + hstepB, voffB); PG8_STAGE(PG8_SA(0, 0), a2, voffA);
            PG8_WAIT_V(8); PG8_WAIT_L(0); PG8_BAR; PG8_MMA(1, 0, At, B0); PG8_MMA(1, 1, At, B1); PG8_BAR; PG8_SCHED;
            PG8_LDB(B0, 1, 0); PG8_LDB(B1, 1, 1); PG8_SCHED; PG8_LDA(At, 1, 0); PG8_STAGE(PG8_SA(0, 1), a2 + hstepA, voffA);
            PG8_WAIT_V(8); PG8_WAIT_L(0); PG8_BAR; PG8_MMA(0, 0, At, B0); PG8_MMA(0, 1, At, B1); PG8_BAR; PG8_SCHED;
            PG8_LDA(At, 1, 1); PG8_STAGE(PG8_SB(1, 0), b3, voffB); PG8_STAGE(PG8_SB(1, 1), b3 + hstepB, voffB); PG8_STAGE(PG8_SA(1, 0), a3, voffA);
            PG8_WAIT_V(8); PG8_WAIT_L(0); PG8_BAR; PG8_MMA(1, 0, At, B0); PG8_MMA(1, 1, At, B1); PG8_BAR; PG8_SCHED;
        }
        if (wr == 0) PG8_BAR;
        E(acc, cur, wr, wc, fr, fq);
        if (!has_next) break;
#pragma unroll
        for (int a = 0; a < 2; ++a)
#pragma unroll
            for (int b = 0; b < 2; ++b)
#pragma unroll
                for (int m = 0; m < 4; ++m)
#pragma unroll
                    for (int n = 0; n < 2; ++n) acc[a][b][m][n] = (f32x4){0.f, 0.f, 0.f, 0.f};
        cur = nxt; cA = nA; cB = nB; ++ui;
        if (wr == 1) PG8_BAR;
    }
    PG8_WAIT_V(0);
    PG8_BAR;
#undef PG8_SA
#undef PG8_SB
#undef PG8_STAGE
#undef PG8_LDA
#undef PG8_LDB
#undef PG8_MMA
#undef PG8_WAIT_V
#undef PG8_WAIT_L
#undef PG8_BAR
#undef PG8_SCHED
}
}

struct Args {
    const float *x, *norm_g, *w_in, *gm_ln_g, *gm_ln_b, *gm_ws, *gm_bs, *conv_w, *conv_b, *dt_bias, *a_log, *d_skip, *ssm_norm_g, *w_out, *pool_w, *pool_b, *pool_scale, *ffn_w_gate, *ffn_w_up, *ffn_w_down;
    float* out; unsigned char* ws; int ph_lo, ph_hi;
};

__device__ __forceinline__ void p0_transpose_item(const float* W, int ldw, int k0, int n0src, bf16_t* WT, int ldt, int dstrow0, LAS float* scr, int lane) {
#pragma unroll 8
    for (int i = 0; i < 32; ++i) { const int kk = 2 * i + (lane >> 5); scr[kk * 33 + (lane & 31)] = W[(size_t)(k0 + kk) * ldw + n0src + (lane & 31)]; }
    asm volatile("s_waitcnt lgkmcnt(0)" ::: "memory");
    const int c = lane & 7;
#pragma unroll
    for (int j = 0; j < 4; ++j) { const int n = (lane >> 3) + 8 * j; const LAS float* s = scr + (8 * c) * 33 + n;
        u32x4 o; o.x = pk2(s[0 * 33], s[1 * 33]); o.y = pk2(s[2 * 33], s[3 * 33]); o.z = pk2(s[4 * 33], s[5 * 33]); o.w = pk2(s[6 * 33], s[7 * 33]);
        *(u32x4*)(WT + (size_t)(dstrow0 + n) * ldt + k0 + 8 * c) = o; }
    asm volatile("s_waitcnt lgkmcnt(0)" ::: "memory");
}

__device__ __forceinline__ void p0_prologue(const Args& a, LAS unsigned char* L, int tid, int wave, int lane) {
    unsigned char* ws = a.ws;
    bf16_t* WIN = (bf16_t*)(ws + WS_WIN); bf16_t* WOUT = (bf16_t*)(ws + WS_WOUT); bf16_t* WGU = (bf16_t*)(ws + WS_WGU); bf16_t* WDN = (bf16_t*)(ws + WS_WDN); bf16_t* WPOOL = (bf16_t*)(ws + WS_WPOOL);
    LAS float* WDT = (LAS float*)L;
    LAS float* scr = (LAS float*)(L + 65536 + wave * 8448);
    for (int k = tid; k < 1024; k += 512) {
        const float* src = a.w_in + (size_t)k * WIN_LD + 5120;
#pragma unroll
        for (int q = 0; q < 4; ++q) { const f32x4 v = *(const f32x4*)(src + 4 * q);
#pragma unroll
            for (int e = 0; e < 4; ++e) WDT[(4 * q + e) * 1024 + k] = v[e]; }
    }
    const int gw = blockIdx.x * 8 + wave, NGW = gridDim.x * 8;
    constexpr int I_IN = 16 * 160, I_OUT = 32 * 32, I_G = 16 * 88, I_D = 44 * 32, I_L = 2 * I_G + I_D, I_P = 128;
    constexpr int NITEMS = I_IN + I_OUT + 2 * I_L + I_P;
    for (int it = gw; it < NITEMS; it += NGW) {
        int r = it;
        if (r < I_IN) { const int kb = r / 160, nb = r % 160, nd = 32 * nb;
            const int ns = nd < 1024 ? nd : (nd < 2048 ? nd + 1024 : (nd < 3072 ? nd - 1024 : nd));
            p0_transpose_item(a.w_in, WIN_LD, 64 * kb, ns, WIN, 1024, nd, scr, lane); continue; } r -= I_IN;
        if (r < I_OUT) { const int kb = r / 32, nb = r % 32; p0_transpose_item(a.w_out, 1024, 64 * kb, 32 * nb, WOUT, 2048, 32 * nb, scr, lane); continue; } r -= I_OUT;
        if (r < 2 * I_L) { const int ly = r / I_L; r -= ly * I_L;
            if (r < 2 * I_G) { const int up = r / I_G; r -= up * I_G; const int kb = r / 88, nb = r % 88, n0 = 32 * nb;
                p0_transpose_item((up ? a.ffn_w_up : a.ffn_w_gate) + (size_t)ly * D * DFF, DFF, 64 * kb, n0, WGU + (size_t)ly * 5632 * 1024, 1024, 256 * (n0 / 128) + 128 * up + (n0 % 128), scr, lane); continue; }
            r -= 2 * I_G; { const int kb = r / 32, nb = r % 32; p0_transpose_item(a.ffn_w_down + (size_t)ly * DFF * D, D, 64 * kb, 32 * nb, WDN + (size_t)ly * 1024 * DFF, DFF, 32 * nb, scr, lane); continue; } }
        r -= 2 * I_L;
        { const int g = r / 32, rr = r % 32, kb = rr / 8, nb = rr % 8; p0_transpose_item(a.pool_w + (size_t)g * 65536, 256, 64 * kb, 32 * nb, WPOOL, 256, 256 * g + 32 * nb, scr, lane); }
    }
    __syncthreads();
    bf16_t* XN = (bf16_t*)(ws + WS_R1); float* DT = (float*)(ws + WS_DT);
    f32x4 gv[4];
#pragma unroll
    for (int j = 0; j < 4; ++j) gv[j] = *(const f32x4*)(a.norm_g + 4 * lane + 256 * j);
    for (int m = gw; m < M; m += NGW) {
        const f32x4* xr = (const f32x4*)(a.x + (size_t)m * D) + lane;
        f32x4 v[4]; float s = 0.f;
#pragma unroll
        for (int j = 0; j < 4; ++j) { v[j] = xr[64 * j]; s += (v[j].x * v[j].x + v[j].y * v[j].y) + (v[j].z * v[j].z + v[j].w * v[j].w); }
        const float rstd = rsqrtf(wave_sum(s) * (1.f / D) + EPS);
        unsigned long long* o8 = (unsigned long long*)(XN + (size_t)m * D) + lane;
#pragma unroll
        for (int j = 0; j < 4; ++j) { v[j] = v[j] * rstd * gv[j]; o8[64 * j] = (unsigned long long)pk2(v[j].x, v[j].y) | ((unsigned long long)pk2(v[j].z, v[j].w) << 32); }
        float mine = 0.f;
#pragma unroll 2
        for (int o = 0; o < 16; ++o) { float p = 0.f;
#pragma unroll
            for (int j = 0; j < 4; ++j) { const f32x4 w = *(const LAS f32x4*)(WDT + o * 1024 + 256 * j + 4 * lane); p += (v[j].x * w.x + v[j].y * w.y) + (v[j].z * w.z + v[j].w * w.w); }
            p = wave_sum(p); if (lane == o) mine = p; }
        if (lane < 16) { const float xx = mine + a.dt_bias[lane]; DT[(size_t)m * 16 + lane] = fmaxf(xx, 0.f) + log1pf(expf(-fabsf(xx))); }
    }
    __syncthreads();
}

__device__ __forceinline__ void ssd_dt_acum(LAS float* ACUM, LAS float* DTL, const float* DT, const float* a_log, int c, int g, int wave, int lane) {
    if (wave < 4) {
        const int h = wave; const float av = -expf(a_log[4 * g + h]);
        const float d0 = DT[(size_t)(c * 128 + 2 * lane) * 16 + 4 * g + h], d1 = DT[(size_t)(c * 128 + 2 * lane + 1) * 16 + 4 * g + h];
        const float v0 = d0 * av, v1 = d1 * av; float s = v0 + v1;
#pragma unroll
        for (int o = 1; o < 64; o <<= 1) { const float t = __shfl_up(s, o); if (lane >= o) s += t; }
        ACUM[h * 128 + 2 * lane] = s - v1; ACUM[h * 128 + 2 * lane + 1] = s;
        DTL[h * 128 + 2 * lane] = d0; DTL[h * 128 + 2 * lane + 1] = d1;
    }
}
__device__ __forceinline__ void conv8(const bf16_t* proj, int tg0, int col, const float (&w)[4][8], const float (&b)[8], float (&o)[8][8]) {
    u32x4 raw[11];
#pragma unroll
    for (int i = 0; i < 11; ++i) { const int t = tg0 - 3 + i; raw[i] = (t >= 0) ? *(const u32x4*)(proj + (size_t)t * LDPROJ + col) : (u32x4){0u, 0u, 0u, 0u}; }
#pragma unroll
    for (int i = 0; i < 8; ++i)
#pragma unroll
        for (int j = 0; j < 8; ++j) { float acc = b[j];
#pragma unroll
            for (int k = 0; k < 4; ++k) { const unsigned wd = raw[i + k][j >> 1]; acc += w[k][j] * ((j & 1) ? bfhi(wd) : bflo(wd)); }
            o[i][j] = fsilu(acc); }
}
__device__ __forceinline__ void load_conv_w(const float* conv_w, const float* conv_b, int ch, float (&w)[4][8], float (&b)[8]) {
#pragma unroll
    for (int k = 0; k < 4; ++k) { const f32x4 a0 = *(const f32x4*)(conv_w + k * 2048 + ch), a1 = *(const f32x4*)(conv_w + k * 2048 + ch + 4);
#pragma unroll
        for (int e = 0; e < 4; ++e) { w[k][e] = a0[e]; w[k][4 + e] = a1[e]; } }
    const f32x4 b0 = *(const f32x4*)(conv_b + ch), b1 = *(const f32x4*)(conv_b + ch + 4);
#pragma unroll
    for (int e = 0; e < 4; ++e) { b[e] = b0[e]; b[4 + e] = b1[e]; }
}
constexpr int LROW = 272;

__device__ __forceinline__ void ssd_states_unit(const Args& a, LAS unsigned char* L, int c, int g, int tid, int wave, int lane) {
    LAS unsigned char* XT = L; LAS unsigned char* BT = L + 69632;
    LAS float* ACUM = (LAS float*)(L + 104448); LAS float* DTL = ACUM + 512;
    const bf16_t* proj = (const bf16_t*)(a.ws + WS_PROJ); const float* DT = (const float*)(a.ws + WS_DT); float* CD = (float*)(a.ws + WS_CD);
    ssd_dt_acum(ACUM, DTL, DT, a.a_log, c, g, wave, lane);
    __syncthreads();
    if (tid < 4) CD[c * 16 + 4 * g + tid] = expf(ACUM[tid * 128 + 127]);
    if (tid < 384) {
        const int oct = tid % 48, tr = tid / 48; const bool isx = oct < 32;
        const int ch = isx ? (256 * g + 8 * oct) : (1024 + 128 * g + 8 * (oct - 32));
        float w[4][8], b[8]; load_conv_w(a.conv_w, a.conv_b, ch, w, b);
        const int h = oct >> 3;
#pragma unroll
        for (int half = 0; half < 2; ++half) {
            float o[8][8]; const int l0 = 16 * tr + 8 * half;
            conv8(proj, c * 128 + l0, COL_XBC + ch, w, b, o);
            if (isx) { const float atot = ACUM[h * 128 + 127];
#pragma unroll
                for (int i = 0; i < 8; ++i) { const float sc = DTL[h * 128 + l0 + i] * __expf(atot - ACUM[h * 128 + l0 + i]);
#pragma unroll
                    for (int j = 0; j < 8; ++j) o[i][j] *= sc; } }
            LAS unsigned char* base = isx ? (XT + (8 * oct) * LROW) : (BT + (8 * (oct - 32)) * LROW);
#pragma unroll
            for (int j = 0; j < 8; ++j) { u32x4 p; p.x = pk2(o[0][j], o[1][j]); p.y = pk2(o[2][j], o[3][j]); p.z = pk2(o[4][j], o[5][j]); p.w = pk2(o[6][j], o[7][j]);
                *(LAS u32x4*)(base + j * LROW + l0 * 2) = p; }
        }
    }
    __syncthreads();
    const int r16 = lane & 15, q = lane >> 4;
    f32x4 acc[2][8];
#pragma unroll
    for (int mi = 0; mi < 2; ++mi)
#pragma unroll
        for (int nt = 0; nt < 8; ++nt) acc[mi][nt] = (f32x4){0.f, 0.f, 0.f, 0.f};
#pragma unroll
    for (int ks = 0; ks < 4; ++ks) {
        bf16x8 P[2];
#pragma unroll
        for (int mi = 0; mi < 2; ++mi) P[mi] = *(const LAS bf16x8*)(XT + (32 * wave + 16 * mi + r16) * LROW + (32 * ks + 8 * q) * 2);
#pragma unroll
        for (int nt = 0; nt < 8; ++nt) { const bf16x8 Q = *(const LAS bf16x8*)(BT + (16 * nt + r16) * LROW + (32 * ks + 8 * q) * 2);
#pragma unroll
            for (int mi = 0; mi < 2; ++mi) acc[mi][nt] = MFMA16(Q, P[mi], acc[mi][nt]); }
    }
    bf16_t* ST = (bf16_t*)(a.ws + WS_R1) + ((size_t)(c * 4 + g) * 256) * 128;
#pragma unroll
    for (int mi = 0; mi < 2; ++mi)
#pragma unroll
        for (int nt = 0; nt < 8; ++nt) { u32x2 p; p.x = pk2(acc[mi][nt][0], acc[mi][nt][1]); p.y = pk2(acc[mi][nt][2], acc[mi][nt][3]);
            *(u32x2*)(ST + (size_t)(32 * wave + 16 * mi + r16) * 128 + 16 * nt + 4 * q) = p; }
    __syncthreads();
}

__device__ __forceinline__ void gmlp_unit(const Args& a, LAS unsigned char* L, int c, int h, int tid, int wave, int lane) {
    LAS unsigned char* VT = L; LAS float* MEAN = (LAS float*)(L + 69632); LAS float* RSTD = MEAN + 128;
    bf16_t* proj = (bf16_t*)(a.ws + WS_PROJ);
    for (int i = 0; i < 16; ++i) {
        const int l = 16 * wave + i; const bf16_t* row = proj + (size_t)(c * 128 + l) * LDPROJ + COL_V;
        const u32x4 r0 = *(const u32x4*)(row + 8 * lane), r1 = *(const u32x4*)(row + 512 + 8 * lane);
        float xv[16];
#pragma unroll
        for (int e = 0; e < 4; ++e) { xv[2 * e] = bflo(r0[e]); xv[2 * e + 1] = bfhi(r0[e]); xv[8 + 2 * e] = bflo(r1[e]); xv[8 + 2 * e + 1] = bfhi(r1[e]); }
        float s = 0.f;
#pragma unroll
        for (int e = 0; e < 16; ++e) s += xv[e];
        const float mean = wave_sum(s) * (1.f / 1024.f); float qv = 0.f;
#pragma unroll
        for (int e = 0; e < 16; ++e) { const float d = xv[e] - mean; qv += d * d; }
        qv = wave_sum(qv);
        if (lane == 0) { MEAN[l] = mean; RSTD[l] = rsqrtf(qv * (1.f / 1024.f) + EPS); }
    }
    __syncthreads();
    {
        const int oct = tid & 31, tg = tid >> 5; const int chn = 256 * h + 8 * oct;
        float gg[8], bb[8];
        { const f32x4 g0 = *(const f32x4*)(a.gm_ln_g + chn), g1 = *(const f32x4*)(a.gm_ln_g + chn + 4), b0 = *(const f32x4*)(a.gm_ln_b + chn), b1 = *(const f32x4*)(a.gm_ln_b + chn + 4);
#pragma unroll
          for (int e = 0; e < 4; ++e) { gg[e] = g0[e]; gg[4 + e] = g1[e]; bb[e] = b0[e]; bb[4 + e] = b1[e]; } }
        float o[8][8];
#pragma unroll
        for (int i = 0; i < 8; ++i) { const int s = 8 * tg + i; const u32x4 raw = *(const u32x4*)(proj + (size_t)(c * 128 + s) * LDPROJ + COL_V + chn);
            const float mu = MEAN[s], rs = RSTD[s];
#pragma unroll
            for (int e = 0; e < 4; ++e) { o[i][2 * e] = (bflo(raw[e]) - mu) * rs * gg[2 * e] + bb[2 * e]; o[i][2 * e + 1] = (bfhi(raw[e]) - mu) * rs * gg[2 * e + 1] + bb[2 * e + 1]; } }
#pragma unroll
        for (int j = 0; j < 8; ++j) { u32x4 p; p.x = pk2(o[0][j], o[1][j]); p.y = pk2(o[2][j], o[3][j]); p.z = pk2(o[4][j], o[5][j]); p.w = pk2(o[6][j], o[7][j]);
            *(LAS u32x4*)(VT + (8 * oct + j) * LROW + (8 * tg) * 2) = p; }
    }
    __syncthreads();
    const int r16 = lane & 15, q = lane >> 4, t = 16 * wave + r16;
    f32x4 acc[16];
#pragma unroll
    for (int d = 0; d < 16; ++d) acc[d] = (f32x4){0.f, 0.f, 0.f, 0.f};
#pragma unroll
    for (int ks = 0; ks < 4; ++ks) if (2 * ks <= wave) {
        const float* wrow = a.gm_ws + ((size_t)h * 128 + t) * 128 + 32 * ks + 8 * q;
        const f32x4 f0 = *(const f32x4*)wrow, f1 = *(const f32x4*)(wrow + 4);
        float wv[8];
#pragma unroll
        for (int e = 0; e < 4; ++e) { wv[e] = f0[e]; wv[4 + e] = f1[e]; }
#pragma unroll
        for (int e = 0; e < 8; ++e) wv[e] = (32 * ks + 8 * q + e <= t) ? wv[e] : 0.f;
        u32x4 pw; pw.x = pk2(wv[0], wv[1]); pw.y = pk2(wv[2], wv[3]); pw.z = pk2(wv[4], wv[5]); pw.w = pk2(wv[6], wv[7]);
        const bf16x8 P = __builtin_bit_cast(bf16x8, pw);
#pragma unroll
        for (int d = 0; d < 16; ++d) { const bf16x8 Q = *(const LAS bf16x8*)(VT + (16 * d + r16) * LROW + (32 * ks + 8 * q) * 2); acc[d] = MFMA16(Q, P, acc[d]); }
    }
    const float bs = a.gm_bs[h * 128 + t];
    bf16_t* urow = proj + (size_t)(c * 128 + t) * LDPROJ + COL_U + 256 * h + 4 * q;
#pragma unroll
    for (int d = 0; d < 16; ++d) { const u32x2 uu = *(const u32x2*)(urow + 16 * d);
        u32x2 p; p.x = pk2((acc[d][0] + bs) * bflo(uu.x), (acc[d][1] + bs) * bfhi(uu.x)); p.y = pk2((acc[d][2] + bs) * bflo(uu.y), (acc[d][3] + bs) * bfhi(uu.y));
        *(u32x2*)(urow + 16 * d) = p; }
    __syncthreads();
}

__device__ __forceinline__ void ssd_scan(const Args& a, int tid) {
    bf16_t* ST = (bf16_t*)(a.ws + WS_R1); const float* CD = (const float*)(a.ws + WS_CD);
    for (int e = blockIdx.x * 512 + tid; e < 131072; e += gridDim.x * 512) {
        const int hh = e >> 13; float st = 0.f;
        for (int c0 = 0; c0 < NCHUNK; c0 += 16) {
            float nw[16], cd[16];
#pragma unroll
            for (int i = 0; i < 16; ++i) { nw[i] = __uint_as_float((unsigned)ST[(size_t)(c0 + i) * 131072 + e] << 16); cd[i] = CD[(c0 + i) * 16 + hh]; }
#pragma unroll
            for (int i = 0; i < 16; ++i) { ST[(size_t)(c0 + i) * 131072 + e] = (bf16_t)(pk2(st, 0.f) & 0xffffu); st = st * cd[i] + nw[i]; }
        }
    }
}

__device__ __forceinline__ void ssd_out_unit(const Args& a, LAS unsigned char* L, int c, int g, int tid, int wave, int lane) {
    LAS unsigned char* CL = L; LAS unsigned char* BL = L + 34816; LAS unsigned char* XT = L + 69632;
    LAS float* ACUM = (LAS float*)(L + 139264); LAS float* DTL = ACUM + 512;
    bf16_t* proj = (bf16_t*)(a.ws + WS_PROJ); const float* DT = (const float*)(a.ws + WS_DT);
    ssd_dt_acum(ACUM, DTL, DT, a.a_log, c, g, wave, lane);
    {
        const int oct = tid & 63, tr = tid >> 6;
        const int ch = oct < 32 ? (256 * g + 8 * oct) : (oct < 48 ? (1024 + 128 * g + 8 * (oct - 32)) : (1536 + 128 * g + 8 * (oct - 48)));
        float w[4][8], b[8]; load_conv_w(a.conv_w, a.conv_b, ch, w, b);
#pragma unroll
        for (int half = 0; half < 2; ++half) {
            float o[8][8]; const int l0 = 16 * tr + 8 * half;
            conv8(proj, c * 128 + l0, COL_XBC + ch, w, b, o);
            if (oct < 32) {
#pragma unroll
                for (int j = 0; j < 8; ++j) { u32x4 p; p.x = pk2(o[0][j], o[1][j]); p.y = pk2(o[2][j], o[3][j]); p.z = pk2(o[4][j], o[5][j]); p.w = pk2(o[6][j], o[7][j]);
                    *(LAS u32x4*)(XT + (8 * oct + j) * LROW + l0 * 2) = p; }
            } else {
                LAS unsigned char* base = (oct < 48 ? BL : CL) + (8 * ((oct - 32) & 15)) * 2;
#pragma unroll
                for (int i = 0; i < 8; ++i) { u32x4 p; p.x = pk2(o[i][0], o[i][1]); p.y = pk2(o[i][2], o[i][3]); p.z = pk2(o[i][4], o[i][5]); p.w = pk2(o[i][6], o[i][7]);
                    *(LAS u32x4*)(base + (l0 + i) * LROW) = p; }
            }
        }
    }
    __syncthreads();
    const int r16 = lane & 15, q = lane >> 4, l = 16 * wave + r16;
    f32x4 cb[8];
#pragma unroll
    for (int t = 0; t < 8; ++t) cb[t] = (f32x4){0.f, 0.f, 0.f, 0.f};
    bf16x8 PC[4];
#pragma unroll
    for (int ks = 0; ks < 4; ++ks) PC[ks] = *(const LAS bf16x8*)(CL + l * LROW + (32 * ks + 8 * q) * 2);
#pragma unroll
    for (int ks = 0; ks < 4; ++ks)
#pragma unroll
        for (int t = 0; t < 8; ++t) if (t <= wave) { const bf16x8 Q = *(const LAS bf16x8*)(BL + (16 * t + r16) * LROW + (32 * ks + 8 * q) * 2); cb[t] = MFMA16(Q, PC[ks], cb[t]); }
    float gated[4][4][4]; float ssq = 0.f;
    const bf16_t* STg = (const bf16_t*)(a.ws + WS_R1) + ((size_t)(c * 4 + g) * 256) * 128;
    const size_t rowoff = (size_t)(c * 128 + l) * LDPROJ + COL_Z + 256 * g + 4 * q;
#pragma unroll
    for (int h = 0; h < 4; ++h) {
        const float al = ACUM[h * 128 + l], Dh = a.d_skip[4 * g + h];
        bf16x8 pf[4];
#pragma unroll
        for (int ks = 0; ks < 4; ++ks) {
            u32x4 wd = (u32x4){0u, 0u, 0u, 0u};
#pragma unroll
            for (int h2 = 0; h2 < 2; ++h2) { const int t = 2 * ks + h2;
                if (t <= wave) {
                    const f32x4 as4 = *(const LAS f32x4*)(ACUM + h * 128 + 16 * t + 4 * q), dt4 = *(const LAS f32x4*)(DTL + h * 128 + 16 * t + 4 * q);
                    float v[4];
#pragma unroll
                    for (int r = 0; r < 4; ++r) { const int s = 16 * t + 4 * q + r; v[r] = (s <= l) ? cb[t][r] * __expf(al - as4[r]) * dt4[r] : 0.f; if (s == l) v[r] += Dh; }
                    wd[2 * h2] = pk2(v[0], v[1]); wd[2 * h2 + 1] = pk2(v[2], v[3]);
                } }
            pf[ks] = __builtin_bit_cast(bf16x8, wd);
        }
        f32x4 acc[4];
#pragma unroll
        for (int pt = 0; pt < 4; ++pt) acc[pt] = (f32x4){0.f, 0.f, 0.f, 0.f};
        const bf16_t* STh = STg + (size_t)(64 * h) * 128;
#pragma unroll
        for (int ks = 0; ks < 4; ++ks)
#pragma unroll
            for (int pt = 0; pt < 4; ++pt) { const bf16x8 Q = *(const bf16x8*)(STh + (size_t)(16 * pt + r16) * 128 + 32 * ks + 8 * q); acc[pt] = MFMA16(Q, PC[ks], acc[pt]); }
        const float ea = __expf(al);
#pragma unroll
        for (int pt = 0; pt < 4; ++pt) acc[pt] = acc[pt] * ea;
#pragma unroll
        for (int ks = 0; ks < 4; ++ks) if (2 * ks <= wave) {
#pragma unroll
            for (int pt = 0; pt < 4; ++pt) { const LAS unsigned char* xr = XT + (64 * h + 16 * pt + r16) * LROW + (32 * ks + 4 * q) * 2;
                const s16x4 lo = *(const LAS s16x4*)xr, hi = *(const LAS s16x4*)(xr + 32);
                const bf16x8 Q = __builtin_shufflevector(lo, hi, 0, 1, 2, 3, 4, 5, 6, 7);
                acc[pt] = MFMA16(Q, pf[ks], acc[pt]); }
        }
#pragma unroll
        for (int pt = 0; pt < 4; ++pt) { const u32x2 zz = *(const u32x2*)(proj + rowoff + 64 * h + 16 * pt);
            const float z0 = bflo(zz.x), z1 = bfhi(zz.x), z2 = bflo(zz.y), z3 = bfhi(zz.y);
            const float g0 = acc[pt][0] * fsilu(z0), g1 = acc[pt][1] * fsilu(z1), g2 = acc[pt][2] * fsilu(z2), g3 = acc[pt][3] * fsilu(z3);
            gated[h][pt][0] = g0; gated[h][pt][1] = g1; gated[h][pt][2] = g2; gated[h][pt][3] = g3; ssq += (g0 * g0 + g1 * g1) + (g2 * g2 + g3 * g3); }
    }
    ssq += __shfl_xor(ssq, 16); ssq += __shfl_xor(ssq, 32);
    const float rstd = rsqrtf(ssq * (1.f / 256.f) + EPS);
#pragma unroll
    for (int h = 0; h < 4; ++h)
#pragma unroll
        for (int pt = 0; pt < 4; ++pt) { const f32x4 ng = *(const f32x4*)(a.ssm_norm_g + 256 * g + 64 * h + 16 * pt + 4 * q);
            u32x2 p; p.x = pk2(gated[h][pt][0] * rstd * ng[0], gated[h][pt][1] * rstd * ng[1]); p.y = pk2(gated[h][pt][2] * rstd * ng[2], gated[h][pt][3] * rstd * ng[3]);
            *(u32x2*)(proj + rowoff + 64 * h + 16 * pt) = p; }
    __syncthreads();
}

__device__ __forceinline__ void norm_pass(const bf16_t* Y, const float* hin, float* hout, bf16_t* xn, const float* g1, const float* g2, int wave, int lane) {
    const int gw = blockIdx.x * 8 + wave, NGW = gridDim.x * 8;
    f32x4 g1v[4], g2v[4];
#pragma unroll
    for (int j = 0; j < 4; ++j) { g1v[j] = *(const f32x4*)(g1 + 4 * lane + 256 * j); g2v[j] = xn ? *(const f32x4*)(g2 + 4 * lane + 256 * j) : (f32x4){0.f, 0.f, 0.f, 0.f}; }
    for (int m = gw; m < M; m += NGW) {
        const u32x2* yr = (const u32x2*)(Y + (size_t)m * D) + lane; const f32x4* hr = (const f32x4*)(hin + (size_t)m * D) + lane;
        f32x4 y[4], hv[4]; float s = 0.f;
#pragma unroll
        for (int j = 0; j < 4; ++j) { const u32x2 w = yr[64 * j]; hv[j] = hr[64 * j]; y[j] = (f32x4){bflo(w.x), bfhi(w.x), bflo(w.y), bfhi(w.y)};
            s += (y[j].x * y[j].x + y[j].y * y[j].y) + (y[j].z * y[j].z + y[j].w * y[j].w); }
        const float rs = rsqrtf(wave_sum(s) * (1.f / D) + EPS); float s2 = 0.f;
#pragma unroll
        for (int j = 0; j < 4; ++j) { hv[j] = hv[j] + y[j] * rs * g1v[j]; s2 += (hv[j].x * hv[j].x + hv[j].y * hv[j].y) + (hv[j].z * hv[j].z + hv[j].w * hv[j].w); }
        f32x4* ho = (f32x4*)(hout + (size_t)m * D) + lane;
#pragma unroll
        for (int j = 0; j < 4; ++j) ho[64 * j] = hv[j];
        if (xn) {
            const float rs2 = rsqrtf(wave_sum(s2) * (1.f / D) + EPS);
            unsigned long long* o8 = (unsigned long long*)(xn + (size_t)m * D) + lane;
#pragma unroll
            for (int j = 0; j < 4; ++j) { const f32x4 v = hv[j] * rs2 * g2v[j]; o8[64 * j] = (unsigned long long)pk2(v.x, v.y) | ((unsigned long long)pk2(v.z, v.w) << 32); }
        }
    }
}

__device__ __forceinline__ void pool_pass(const bf16_t* xn, bf16_t* dp, int tid) {
    const int win = 2 << (tid >> 7);
    for (int u = blockIdx.x; u < M / 32; u += gridDim.x) {
        const int t0 = 32 * u; const unsigned* base = (const unsigned*)xn + tid;
        float s0 = 0.f, s1 = 0.f;
        for (int j = 1; j < win; ++j) { const int tt = t0 - j; if (tt >= 0) { const unsigned w = base[(size_t)tt * 512]; s0 += bflo(w); s1 += bfhi(w); } }
#pragma unroll 4
        for (int i = 0; i < 32; ++i) { const int t = t0 + i; const unsigned w = base[(size_t)t * 512]; const float c0 = bflo(w), c1 = bfhi(w);
            s0 += c0; s1 += c1; const float inv = 1.f / (float)((t + 1 < win) ? (t + 1) : win);
            ((unsigned*)dp)[(size_t)t * 512 + tid] = pk2(s0 * inv - c0, s1 * inv - c1);
            const int old = t - win + 1; if (old >= 0) { const unsigned wo = base[(size_t)old * 512]; s0 -= bflo(wo); s1 -= bfhi(wo); } }
    }
}

__global__ void __launch_bounds__(512, 2) fwd_kernel(Args a) {
    extern __shared__ __attribute__((aligned(16))) unsigned char lds_raw[];
    LAS unsigned char* L = (LAS unsigned char*)lds_raw;
    const int tid = threadIdx.x, lane = tid & 63, wave = __builtin_amdgcn_readfirstlane(tid >> 6);
    const int lo = a.ph_lo, hi = a.ph_hi, G = gridDim.x;
    unsigned char* ws = a.ws;
    bf16_t* WIN = (bf16_t*)(ws + WS_WIN); bf16_t* WOUT = (bf16_t*)(ws + WS_WOUT); bf16_t* WGU = (bf16_t*)(ws + WS_WGU); bf16_t* WDN = (bf16_t*)(ws + WS_WDN); bf16_t* WPOOL = (bf16_t*)(ws + WS_WPOOL);
    bf16_t* R1 = (bf16_t*)(ws + WS_R1); bf16_t* PROJ = (bf16_t*)(ws + WS_PROJ);
    bf16_t* XN2 = PROJ;
    bf16_t* HID = (bf16_t*)(ws + WS_PROJ + 32 * MiB);
#ifndef PHMASK
#define PHMASK 0xffff
#endif
#define IN(k) (((PHMASK >> (k)) & 1) && lo <= (k) && (k) < hi)
#if ONE_LAUNCH
#define SEAM(k) do { if (IN(k) && IN((k) + 1)) cg::this_grid().sync(); } while (0)
#else
#define SEAM(k) do { } while (0)
#endif
    if (IN(0)) { p0_prologue(a, L, tid, wave, lane); } SEAM(0);
    if (IN(1)) { pg8::Gemm g{R1, WIN, M, 5120, 1024, 1024, 1024, 0}; pg8::StaticOrder S; S.init(M, 5120, G, blockIdx.x); pg8::EpiProj E{PROJ, LDPROJ}; pg8::gemm_phase(L, g, S, E); } SEAM(1);
    if (IN(2)) { for (int u = blockIdx.x; u < 1024; u += G) { const int k = u & 511; if (u < 512) ssd_states_unit(a, L, k >> 2, k & 3, tid, wave, lane); else gmlp_unit(a, L, k >> 2, k & 3, tid, wave, lane); } } SEAM(2);
    if (IN(3)) { ssd_scan(a, tid); } SEAM(3);
    if (IN(4)) { for (int u = blockIdx.x; u < 512; u += G) ssd_out_unit(a, L, u >> 2, u & 3, tid, wave, lane); } SEAM(4);
    if (IN(5)) { pg8::Gemm g{PROJ, WOUT, M, 1024, 2048, LDPROJ, 2048, 0}; pg8::StaticOrder S; S.init(M, 1024, G, blockIdx.x); pg8::EpiY E{R1, 1024, nullptr, nullptr}; pg8::gemm_phase(L, g, S, E); } SEAM(5);
    if (IN(6)) { norm_pass(R1, a.x, a.out, XN2, a.norm_g + 1 * D, a.norm_g + 2 * D, wave, lane); } SEAM(6);
    if (IN(7)) { pg8::Gemm g{XN2, WGU, M, 5632, 1024, 1024, 1024, 0}; pg8::StaticOrder S; S.init(M, 5632, G, blockIdx.x); pg8::EpiSwiGLU E{HID, DFF}; pg8::gemm_phase(L, g, S, E); } SEAM(7);
    if (IN(8)) { pg8::Gemm g{HID, WDN, M, 1024, DFF, DFF, DFF, 0}; pg8::StaticOrder S; S.init(M, 1024, G, blockIdx.x); pg8::EpiY E{R1, 1024, nullptr, nullptr}; pg8::gemm_phase(L, g, S, E); } SEAM(8);
    if (IN(9)) { norm_pass(R1, a.out, a.out, XN2, a.norm_g + 3 * D, a.norm_g + 4 * D, wave, lane); } SEAM(9);
    if (IN(10)) { pool_pass(XN2, HID, tid); } SEAM(10);
    if (IN(11)) { pg8::Gemm g{HID, WPOOL, M, 1024, 256, 1024, 256, 512}; pg8::StaticOrder S; S.init(M, 1024, G, blockIdx.x); pg8::EpiY E{R1, 1024, a.pool_b, a.pool_scale}; pg8::gemm_phase(L, g, S, E); } SEAM(11);
    if (IN(12)) { norm_pass(R1, a.out, a.out, XN2, a.norm_g + 5 * D, a.norm_g + 6 * D, wave, lane); } SEAM(12);
    if (IN(13)) { pg8::Gemm g{XN2, WGU + (size_t)5632 * 1024, M, 5632, 1024, 1024, 1024, 0}; pg8::StaticOrder S; S.init(M, 5632, G, blockIdx.x); pg8::EpiSwiGLU E{HID, DFF}; pg8::gemm_phase(L, g, S, E); } SEAM(13);
    if (IN(14)) { pg8::Gemm g{HID, WDN + (size_t)1024 * DFF, M, 1024, DFF, DFF, DFF, 0}; pg8::StaticOrder S; S.init(M, 1024, G, blockIdx.x); pg8::EpiY E{R1, 1024, nullptr, nullptr}; pg8::gemm_phase(L, g, S, E); } SEAM(14);
    if (IN(15)) { norm_pass(R1, a.out, a.out, nullptr, a.norm_g + 7 * D, nullptr, wave, lane); }
#undef IN
#undef SEAM
}

extern "C" void kernel_launch(void* const* d_in, const int* in_sizes, int n_in, void* d_out, int out_size, void* d_ws, size_t ws_size, hipStream_t stream) {
    static int grid = 0;
    if (grid == 0) {
        if (n_in != 20 || out_size != M * D || ws_size < WS_END) { fprintf(stderr, "kernel_launch: unexpected shapes (n_in %d out %d ws %zu)\n", n_in, out_size, ws_size); grid = -1; return; }
        int dev = 0, cus = 0, per_cu = 0;
        (void)hipGetDevice(&dev); (void)hipDeviceGetAttribute(&cus, hipDeviceAttributeMultiprocessorCount, dev);
        if (hipFuncSetAttribute((const void*)fwd_kernel, hipFuncAttributeMaxDynamicSharedMemorySize, LDS_BYTES) != hipSuccess) { fprintf(stderr, "kernel_launch: hipFuncSetAttribute failed\n"); }
        (void)hipOccupancyMaxActiveBlocksPerMultiprocessor(&per_cu, (const void*)fwd_kernel, 512, LDS_BYTES);
        (void)hipGetLastError();
        if (per_cu < 1) { fprintf(stderr, "kernel_launch: occupancy query says %d blocks per CU\n", per_cu); per_cu = 1; }
        grid = cus;
        fprintf(stderr, "kernel_launch: grid %d (per_cu %d)\n", grid, per_cu);
    }
    if (grid < 0) return;
    Args a{};
    const float** ap = (const float**)&a;
    for (int i = 0; i < 20; ++i) ap[i] = (const float*)d_in[i];
    a.out = (float*)d_out; a.ws = (unsigned char*)d_ws;
#if ONE_LAUNCH
    a.ph_lo = 0; a.ph_hi = NPHASE;
    void* args[] = {&a};
    hipError_t e = hipLaunchCooperativeKernel((const void*)fwd_kernel, dim3(grid), dim3(512), args, LDS_BYTES, stream);
    if (e != hipSuccess) fprintf(stderr, "cooperative launch failed: %s (grid %d)\n", hipGetErrorString(e), grid);
#else
    for (int p = 0; p < NPHASE; ++p) { a.ph_lo = p; a.ph_hi = p + 1; hipLaunchKernelGGL(fwd_kernel, dim3(grid), dim3(512), LDS_BYTES, stream, a); }
#endif
}
```

```cpp
#include <hip/hip_runtime.h>
#include <hip/hip_cooperative_groups.h>
#include <cstdio>
#include <cstdint>
namespace cg = cooperative_groups;

#define LAS __attribute__((address_space(3)))
typedef unsigned short bf16_t;
typedef short bf16x8 __attribute__((ext_vector_type(8)));
typedef short s16x4 __attribute__((ext_vector_type(4)));
typedef float f32x4 __attribute__((ext_vector_type(4)));
typedef float f32x2 __attribute__((ext_vector_type(2)));
typedef unsigned u32x4 __attribute__((ext_vector_type(4)));
typedef unsigned u32x2 __attribute__((ext_vector_type(2)));

#ifndef ONE_LAUNCH
#define ONE_LAUNCH 1
#endif

constexpr int M = 16384, D = 1024, DFF = 2816, LDPROJ = 5120, WIN_LD = 5136, NCHUNK = 128;
constexpr float EPS = 1e-6f;
constexpr int NPHASE = 16;
constexpr int COL_U = 0, COL_Z = 1024, COL_V = 2048, COL_XBC = 3072;
constexpr size_t MiB = 1u << 20;
constexpr size_t WS_WIN = 1 * MiB, WS_WOUT = 11 * MiB, WS_WGU = 15 * MiB, WS_WDN = 37 * MiB, WS_WPOOL = 48 * MiB, WS_DT = 49 * MiB, WS_CD = 50 * MiB,
                 WS_R1 = 51 * MiB, WS_PROJ = 83 * MiB, WS_END = 243 * MiB;
constexpr int LDS_BYTES = 147456;

typedef __bf16 bf16x2_t __attribute__((ext_vector_type(2)));
__device__ __forceinline__ unsigned pk2(float lo, float hi) { const f32x2 f = {lo, hi}; const bf16x2_t v = __builtin_convertvector(f, bf16x2_t); return __builtin_bit_cast(unsigned, v); }
__device__ __forceinline__ float bflo(unsigned w) { return __uint_as_float(w << 16); }
__device__ __forceinline__ float bfhi(unsigned w) { return __uint_as_float(w & 0xffff0000u); }
__device__ __forceinline__ float fsilu(float x) { return x * __builtin_amdgcn_rcpf(1.f + __builtin_amdgcn_exp2f(-1.4426950409f * x)); }
__device__ __forceinline__ float gelu_tanh(float x) { const float z = 1.5957691216f * (x + 0.044715f * x * x * x); return x * __builtin_amdgcn_rcpf(1.f + __builtin_amdgcn_exp2f(-1.4426950409f * z)); }
__device__ __forceinline__ float wave_sum(float v) {
#pragma unroll
    for (int o = 1; o < 64; o <<= 1) v += __shfl_xor(v, o);
    return v;
}
#define MFMA16(a, b, c) __builtin_amdgcn_mfma_f32_16x16x32_bf16((a), (b), (c), 0, 0, 0)

namespace pg8 {
constexpr int BM = 256, BK = 64, HALF = 128, HTB = HALF * BK * 2, STAGE_BYTES = 8 * HTB, NXCD = 8, WGM = 8;
__host__ __device__ __forceinline__ int lds_byte(int r, int c) { const int st = (r >> 4) * 2 + (c >> 5), rr = r & 15, cc = c & 31, ob = rr * 64 + cc * 2; return st * 1024 + (ob ^ (((ob >> 9) & 1) << 5)); }
__host__ __device__ __forceinline__ void stage_rc(int b, int& R, int& C) { const int st = b / 1024, sb = b % 1024, swz = sb ^ (((sb >> 9) & 1) << 5); R = (st >> 1) * 16 + swz / 64; C = (st & 1) * 32 + (swz % 64) / 2; }
__host__ __device__ __forceinline__ int perm32(int rho) { const int n = rho >> 4, i = rho & 15; return 8 * (i >> 2) + 4 * n + (i & 3); }

struct Unit { int pm, pn; };
struct Gemm { const bf16_t* A; const bf16_t* Bt; int M, N, K, lda, ldb, a_col_step  ; };

struct StaticOrder {
    int nM, nN, nwg, G, c, rs;
    __device__ void init(int M_, int N_, int G_, int c_, int rs_ = 0) { nM = M_ / BM; nN = N_ / BM; nwg = nM * nN; G = G_; c = c_; rs = rs_; }
    __device__ bool next(int i, Unit& u) const {
        const long L = (long)(i >> rs) * G + c; if (L >= nwg) return false;
        int wgid = (int)L; { const int q = nwg / NXCD, r = nwg % NXCD, xcd = wgid % NXCD, off = wgid / NXCD; wgid = (xcd < r ? xcd * (q + 1) : r * (q + 1) + (xcd - r) * q) + off; }
        const int nig = WGM * nN, gid = wgid / nig, fm = gid * WGM, gsz = (nM - fm) < WGM ? (nM - fm) : WGM;
        u.pm = fm + ((wgid % nig) % gsz); u.pn = (wgid % nig) / gsz; return true;
    }
};

struct EpiProj {
    bf16_t* O; int ldc;
    __device__ __forceinline__ void operator()(const f32x4 (&acc)[2][2][4][2], const Unit& u, int wr, int wc, int fr, int fq) const {
        const bool act = (u.pn < 4) || (u.pn >= 8 && u.pn < 12);
        const int row0 = u.pm * BM + wr * 64 + fr, col0 = u.pn * BM + wc * 32 + 8 * fq;
#pragma unroll
        for (int ai = 0; ai < 2; ++ai)
#pragma unroll
            for (int m = 0; m < 4; ++m) { bf16_t* rowp = O + (size_t)(row0 + ai * HALF + m * 16) * ldc + col0;
#pragma unroll
                for (int bj = 0; bj < 2; ++bj) { f32x4 v0 = acc[ai][bj][m][0], v1 = acc[ai][bj][m][1];
                    if (act) {
#pragma unroll
                        for (int e = 0; e < 4; ++e) { v0[e] = gelu_tanh(v0[e]); v1[e] = gelu_tanh(v1[e]); } }
                    u32x4 w; w.x = pk2(v0[0], v0[1]); w.y = pk2(v0[2], v0[3]); w.z = pk2(v1[0], v1[1]); w.w = pk2(v1[2], v1[3]);
                    *(u32x4*)(rowp + bj * HALF) = w; } }
    }
};
struct EpiSwiGLU {
    bf16_t* O; int ldc;
    __device__ __forceinline__ void operator()(const f32x4 (&acc)[2][2][4][2], const Unit& u, int wr, int wc, int fr, int fq) const {
        const int row0 = u.pm * BM + wr * 64 + fr, col0 = u.pn * HALF + wc * 32 + 8 * fq;
#pragma unroll
        for (int ai = 0; ai < 2; ++ai)
#pragma unroll
            for (int m = 0; m < 4; ++m) { bf16_t* rowp = O + (size_t)(row0 + ai * HALF + m * 16) * ldc + col0;
                f32x4 h0, h1;
#pragma unroll
                for (int e = 0; e < 4; ++e) { h0[e] = fsilu(acc[ai][0][m][0][e]) * acc[ai][1][m][0][e]; h1[e] = fsilu(acc[ai][0][m][1][e]) * acc[ai][1][m][1][e]; }
                u32x4 w; w.x = pk2(h0[0], h0[1]); w.y = pk2(h0[2], h0[3]); w.z = pk2(h1[0], h1[1]); w.w = pk2(h1[2], h1[3]);
                *(u32x4*)rowp = w; }
    }
};
struct EpiY {
    bf16_t* O; int ldc; const float* bias; const float* scale;
    __device__ __forceinline__ void operator()(const f32x4 (&acc)[2][2][4][2], const Unit& u, int wr, int wc, int fr, int fq) const {
        const int row0 = u.pm * BM + wr * 64 + fr, col0 = u.pn * BM + wc * 32 + 8 * fq;
        f32x4 bv[2][2], sv[2][2];
#pragma unroll
        for (int bj = 0; bj < 2; ++bj)
#pragma unroll
            for (int n = 0; n < 2; ++n) { bv[bj][n] = bias ? *(const f32x4*)(bias + col0 + bj * HALF + 4 * n) : (f32x4){0.f, 0.f, 0.f, 0.f};
                                          sv[bj][n] = scale ? *(const f32x4*)(scale + col0 + bj * HALF + 4 * n) : (f32x4){1.f, 1.f, 1.f, 1.f}; }
#pragma unroll
        for (int ai = 0; ai < 2; ++ai)
#pragma unroll
            for (int m = 0; m < 4; ++m) { bf16_t* rowp = O + (size_t)(row0 + ai * HALF + m * 16) * ldc + col0;
#pragma unroll
                for (int bj = 0; bj < 2; ++bj) { const f32x4 v0 = (acc[ai][bj][m][0] + bv[bj][0]) * sv[bj][0], v1 = (acc[ai][bj][m][1] + bv[bj][1]) * sv[bj][1];
                    u32x4 w; w.x = pk2(v0[0], v0[1]); w.y = pk2(v0[2], v0[3]); w.z = pk2(v1[0], v1[1]); w.w = pk2(v1[2], v1[3]);
                    *(u32x4*)(rowp + bj * HALF) = w; } }
    }
};

template <class Epi>
__device__ __forceinline__ void gemm_phase(LAS unsigned char* lds, const Gemm g, const StaticOrder& S, const Epi& E) {
    const int tid = threadIdx.x, wid = __builtin_amdgcn_readfirstlane(tid >> 6), lane = tid & 63, wr = wid >> 2, wc = wid & 3, fr = lane & 15, fq = lane >> 4;
    const int K = g.K, nt = K / BK;
    unsigned voffA[2], voffB[2];
#pragma unroll
    for (int i = 0; i < 2; ++i) { int R, C; stage_rc(tid * 16 + i * 8192, R, C); const int Rb = (R & ~31) + perm32(R & 31);
        voffA[i] = (unsigned)(R * g.lda + C) * 2u; voffB[i] = (unsigned)(Rb * g.ldb + C) * 2u; }
    const size_t kstep = (size_t)(BK * 2);
    const size_t hstepA = (size_t)HALF * g.lda * 2, hstepB = (size_t)HALF * g.ldb * 2;
    const size_t tstepA = 2 * hstepA, tstepB = 2 * hstepB;
    const unsigned ldsw = (unsigned)wid * 1024u;
    const int aoff = lds_byte(wr * 64 + fr, fq * 8), boff = lds_byte(wc * 32 + fr, fq * 8);
#define PG8_SA(b, h) (((b) * 2 + (h)) * HTB)
#define PG8_SB(b, h) ((4 + (b) * 2 + (h)) * HTB)
#define PG8_STAGE(bufoff, gbase, voff) do { _Pragma("unroll") for (int _i = 0; _i < 2; ++_i) \
        __builtin_amdgcn_global_load_lds((const unsigned*)((const char*)(gbase) + (voff)[_i]), (LAS unsigned*)(lds + (bufoff) + ldsw + _i * 8192), 16, 0, 0); } while (0)
#define PG8_LDA(dst, b, h) do { _Pragma("unroll") for (int m = 0; m < 4; ++m) _Pragma("unroll") for (int k = 0; k < 2; ++k) dst[m][k] = *(const LAS bf16x8*)(lds + PG8_SA(b, h) + aoff + m * 2048 + k * 1024); } while (0)
#define PG8_LDB(dst, b, h) do { _Pragma("unroll") for (int n = 0; n < 2; ++n) _Pragma("unroll") for (int k = 0; k < 2; ++k) dst[n][k] = *(const LAS bf16x8*)(lds + PG8_SB(b, h) + boff + n * 2048 + k * 1024); } while (0)
#define PG8_MMA(ai, bj, At, Bt) do { __builtin_amdgcn_s_setprio(1); _Pragma("unroll") for (int m = 0; m < 4; ++m) _Pragma("unroll") for (int n = 0; n < 2; ++n) _Pragma("unroll") for (int k = 0; k < 2; ++k) \
        acc[ai][bj][m][n] = __builtin_amdgcn_mfma_f32_16x16x32_bf16(Bt[n][k], At[m][k], acc[ai][bj][m][n], 0, 0, 0); __builtin_amdgcn_s_setprio(0); } while (0)
#define PG8_WAIT_V(n) asm volatile("s_waitcnt vmcnt(" #n ")" ::: "memory")
#define PG8_WAIT_L(n) asm volatile("s_waitcnt lgkmcnt(" #n ")" ::: "memory")
#define PG8_BAR __builtin_amdgcn_s_barrier()
#define PG8_SCHED __builtin_amdgcn_sched_barrier(0)
    Unit cur, nxt; int ui = 0;
    if (!S.next(0, cur)) return;
    f32x4 acc[2][2][4][2];
#pragma unroll
    for (int a = 0; a < 2; ++a)
#pragma unroll
        for (int b = 0; b < 2; ++b)
#pragma unroll
            for (int m = 0; m < 4; ++m)
#pragma unroll
                for (int n = 0; n < 2; ++n) acc[a][b][m][n] = (f32x4){0.f, 0.f, 0.f, 0.f};
    bf16x8 At[4][2], B0[2][2], B1[2][2];
    const char* cA = (const char*)g.A + (size_t)cur.pm * tstepA + (size_t)cur.pn * g.a_col_step; const char* cB = (const char*)g.Bt + (size_t)cur.pn * tstepB;
    PG8_STAGE(PG8_SB(0, 0), cB, voffB); PG8_STAGE(PG8_SB(0, 1), cB + hstepB, voffB); PG8_STAGE(PG8_SA(0, 0), cA, voffA); PG8_STAGE(PG8_SA(0, 1), cA + hstepA, voffA);
    if (wr == 1) PG8_BAR;
    PG8_WAIT_V(2); PG8_BAR;
    PG8_STAGE(PG8_SB(1, 0), cB + kstep, voffB); PG8_STAGE(PG8_SA(1, 0), cA + kstep, voffA); PG8_STAGE(PG8_SB(1, 1), cB + hstepB + kstep, voffB);
    PG8_WAIT_V(6); PG8_BAR;
    for (;;) {
        const bool has_next = S.next(ui + 1, nxt);
        const char* nA = has_next ? (const char*)g.A + (size_t)nxt.pm * tstepA + (size_t)nxt.pn * g.a_col_step : cA; const char* nB = has_next ? (const char*)g.Bt + (size_t)nxt.pn * tstepB : cB;
        for (int t = 0; t < nt; t += 2) {
            const bool last = (t == nt - 2);
            const char* a1 = cA + (size_t)(t + 1) * kstep;
            const char* a2 = last ? nA : cA + (size_t)(t + 2) * kstep; const char* b2 = last ? nB : cB + (size_t)(t + 2) * kstep;
            const char* a3 = a2 + kstep; const char* b3 = b2 + kstep;
            PG8_LDB(B0, 0, 0); PG8_LDB(B1, 0, 1); PG8_SCHED; PG8_LDA(At, 0, 0); PG8_STAGE(PG8_SA(1, 1), a1 + hstepA, voffA);
            PG8_WAIT_V(8); PG8_WAIT_L(0); PG8_BAR; PG8_MMA(0, 0, At, B0); PG8_MMA(0, 1, At, B1); PG8_BAR; PG8_SCHED;
            PG8_LDA(At, 0, 1); PG8_STAGE(PG8_SB(0, 0), b2, voffB); PG8_STAGE(PG8_SB(0, 1), b2 + hstepB, voffB); PG8_STAGE(PG8_SA(0, 0), a2, voffA);
            PG8_WAIT_V(8); PG8_WAIT_L(0); PG8_BAR; PG8_MMA(1, 0, At, B0); PG8_MMA(1, 1, At, B1); PG8_BAR; PG8_SCHED;
            PG8_LDB(B0, 1, 0); PG8_LDB(B1, 1, 1); PG8_SCHED; PG8_LDA(At, 1, 0); PG8_STAGE(PG8_SA(0, 1), a2 + hstepA, voffA);
            PG8_WAIT_V(8); PG8_WAIT_L(0); PG8_BAR; PG8_MMA(0, 0, At, B0); PG8_MMA(0, 1, At, B1); PG8_BAR; PG8_SCHED;
            PG8_LDA(At, 1, 1); PG8_STAGE(PG8_SB(1, 0), b3, voffB); PG8_STAGE(PG8_SB(1, 1), b3 + hstepB, voffB); PG8_STAGE(PG8_SA(1, 0), a3, voffA);
            PG8_WAIT_V(8); PG8_WAIT_L(0); PG8_BAR; PG8_MMA(1, 0, At, B0); PG8_MMA(1, 1, At, B1); PG8_BAR; PG8_SCHED;
        }
        if (wr == 0) PG8_BAR;
        E(acc, cur, wr, wc, fr, fq);
        if (!has_next) break;
#pragma unroll
        for (int a = 0; a < 2; ++a)
#pragma unroll
            for (int b = 0; b < 2; ++b)
#pragma unroll
                for (int m = 0; m < 4; ++m)
#pragma unroll
                    for (int n = 0; n < 2; ++n) acc[a][b][m][n] = (f32x4){0.f, 0.f, 0.f, 0.f};
        cur = nxt; cA = nA; cB = nB; ++ui;
        if (wr == 1) PG8_BAR;
    }
    PG8_WAIT_V(0);
    PG8_BAR;
#undef PG8_SA
#undef PG8_SB
#undef PG8_STAGE
#undef PG8_LDA
#undef PG8_LDB
#undef PG8_MMA
#undef PG8_WAIT_V
#undef PG8_WAIT_L
#undef PG8_BAR
#undef PG8_SCHED
}
}

#define XB_TMO      128
#define XB_XCNT(j)  (256  + 64 * (j))
#define XB_XSUB(j)  (1280 + 64 * (j))
#define XB_XGEN(j)  (2304 + 64 * (j))
#define XB_TOP      3328
#define XB_TOPGEN   3392
#define XCD_BAR_WORDS 3456
#define XB_SPIN_CAP (1u << 20)
__device__ __forceinline__ unsigned xb_ld(unsigned* p)              { return __hip_atomic_load(p, __ATOMIC_RELAXED, __HIP_MEMORY_SCOPE_AGENT); }
__device__ __forceinline__ unsigned xb_add(unsigned* p, unsigned v) { return __hip_atomic_fetch_add(p, v, __ATOMIC_RELAXED, __HIP_MEMORY_SCOPE_AGENT); }
__device__ __forceinline__ unsigned xb_xcc_id() { return (unsigned)__builtin_amdgcn_s_getreg((3 << 11) | 20) & 0xFu; }
#define XB_SPIN(cond, bar) do { unsigned _sp = 0; while (cond) { __builtin_amdgcn_s_sleep(1); \
    if ((++_sp & 255u) == 0u) { if (xb_ld(&(bar)[XB_TMO])) break; if (_sp > XB_SPIN_CAP) { atomicAdd(&(bar)[XB_TMO], 1u); break; } } } } while (0)
struct XcdBarrier { unsigned* bar; unsigned x; volatile LAS unsigned* st; };
__device__ __forceinline__ XcdBarrier xcd_barrier_post(unsigned* bar, volatile LAS unsigned* st) {
    XcdBarrier b; b.bar = bar; b.x = xb_xcc_id(); b.st = st;
    if (threadIdx.x == 0) (void)xb_add(&bar[XB_XCNT(b.x)], 1u);
    return b;
}
__device__ __forceinline__ void xcd_barrier_complete(unsigned* bar, unsigned x, unsigned& nloc, unsigned& nx) {
    const unsigned G = gridDim.x * gridDim.y * gridDim.z;
    unsigned sum, cnt, mine, sp = 0u;
    for (;;) {
        sum = 0u; cnt = 0u; mine = 0u;
#pragma unroll
        for (unsigned j = 0; j < 16; ++j) { const unsigned c = xb_ld(&bar[XB_XCNT(j)]); sum += c; cnt += (c > 0u) ? 1u : 0u; mine = (j == x) ? c : mine; }
        if (sum == G) break;
        __builtin_amdgcn_s_sleep(1);
        if ((++sp & 255u) == 0u) { if (xb_ld(&bar[XB_TMO])) break; if (sp > XB_SPIN_CAP) { atomicAdd(&bar[XB_TMO], 1u); break; } }
    }
    nloc = mine > 0u ? mine : 1u; nx = cnt > 0u ? cnt : 1u;
}
__device__ __forceinline__ void xcd_barrier(const XcdBarrier& b) {
    asm volatile("s_waitcnt vmcnt(0)" ::: "memory");
    __syncthreads();
    if (threadIdx.x == 0) {
        unsigned* bar = b.bar;
        __builtin_amdgcn_s_waitcnt(0);
        unsigned nloc = b.st[0], nx = b.st[1];
        if (nloc == 0u) { xcd_barrier_complete(bar, b.x, nloc, nx); b.st[0] = nloc; b.st[1] = nx; }
        const unsigned old = xb_add(&bar[XB_XSUB(b.x)], 1u);
        const unsigned gen = old / nloc;
        if (old + 1u == (gen + 1u) * nloc) {
            __builtin_amdgcn_fence(__ATOMIC_RELEASE, "agent");
            asm volatile("s_waitcnt vmcnt(0)" ::: "memory");
            const unsigned og = xb_add(&bar[XB_TOP], 1u);
            const unsigned tg = og / nx;
            if (og + 1u == (tg + 1u) * nx) xb_add(&bar[XB_TOPGEN], 1u);
            else XB_SPIN(xb_ld(&bar[XB_TOPGEN]) == tg, bar);
            __builtin_amdgcn_fence(__ATOMIC_ACQUIRE, "agent");
            xb_add(&bar[XB_XGEN(b.x)], 1u);
            asm volatile("s_waitcnt vmcnt(0)" ::: "memory");
        } else {
            XB_SPIN(xb_ld(&bar[XB_XGEN(b.x)]) == gen, bar);
            __builtin_amdgcn_fence(__ATOMIC_ACQUIRE, "agent");
            asm volatile("s_waitcnt vmcnt(0)" ::: "memory");
        }
    }
    __syncthreads();
}

struct Args {
    const float *x, *norm_g, *w_in, *gm_ln_g, *gm_ln_b, *gm_ws, *gm_bs, *conv_w, *conv_b, *dt_bias, *a_log, *d_skip, *ssm_norm_g, *w_out, *pool_w, *pool_b, *pool_scale, *ffn_w_gate, *ffn_w_up, *ffn_w_down;
    float* out; unsigned char* ws; int ph_lo, ph_hi;
};

__device__ __forceinline__ void p0_transpose_item(const float* W, int ldw, int k0, int n0src, bf16_t* WT, int ldt, int dstrow0, LAS float* scr, int lane) {
#pragma unroll 8
    for (int i = 0; i < 32; ++i) { const int kk = 2 * i + (lane >> 5); scr[kk * 33 + (lane & 31)] = W[(size_t)(k0 + kk) * ldw + n0src + (lane & 31)]; }
    asm volatile("s_waitcnt lgkmcnt(0)" ::: "memory");
    const int c = lane & 7;
#pragma unroll
    for (int j = 0; j < 4; ++j) { const int n = (lane >> 3) + 8 * j; const LAS float* s = scr + (8 * c) * 33 + n;
        u32x4 o; o.x = pk2(s[0 * 33], s[1 * 33]); o.y = pk2(s[2 * 33], s[3 * 33]); o.z = pk2(s[4 * 33], s[5 * 33]); o.w = pk2(s[6 * 33], s[7 * 33]);
        *(u32x4*)(WT + (size_t)(dstrow0 + n) * ldt + k0 + 8 * c) = o; }
    asm volatile("s_waitcnt lgkmcnt(0)" ::: "memory");
}

__device__ __forceinline__ void p0_prologue(const Args& a, LAS unsigned char* L, int tid, int wave, int lane) {
    unsigned char* ws = a.ws;
    bf16_t* WIN = (bf16_t*)(ws + WS_WIN); bf16_t* WOUT = (bf16_t*)(ws + WS_WOUT); bf16_t* WGU = (bf16_t*)(ws + WS_WGU); bf16_t* WDN = (bf16_t*)(ws + WS_WDN); bf16_t* WPOOL = (bf16_t*)(ws + WS_WPOOL);
    LAS float* WDT = (LAS float*)L;
    LAS float* scr = (LAS float*)(L + 65536 + wave * 8448);
    for (int k = tid; k < 1024; k += 512) {
        const float* src = a.w_in + (size_t)k * WIN_LD + 5120;
#pragma unroll
        for (int q = 0; q < 4; ++q) { const f32x4 v = *(const f32x4*)(src + 4 * q);
#pragma unroll
            for (int e = 0; e < 4; ++e) WDT[(4 * q + e) * 1024 + k] = v[e]; }
    }
    const int gw = blockIdx.x * 8 + wave, NGW = gridDim.x * 8;
    constexpr int I_IN = 16 * 160, I_OUT = 32 * 32, I_G = 16 * 88, I_D = 44 * 32, I_L = 2 * I_G + I_D, I_P = 128;
    constexpr int NITEMS = I_IN + I_OUT + 2 * I_L + I_P;
    for (int it = gw; it < NITEMS; it += NGW) {
        int r = it;
        if (r < I_IN) { const int kb = r / 160, nb = r % 160, nd = 32 * nb;
            const int ns = nd < 1024 ? nd : (nd < 2048 ? nd + 1024 : (nd < 3072 ? nd - 1024 : nd));
            p0_transpose_item(a.w_in, WIN_LD, 64 * kb, ns, WIN, 1024, nd, scr, lane); continue; } r -= I_IN;
        if (r < I_OUT) { const int kb = r / 32, nb = r % 32; p0_transpose_item(a.w_out, 1024, 64 * kb, 32 * nb, WOUT, 2048, 32 * nb, scr, lane); continue; } r -= I_OUT;
        if (r < 2 * I_L) { const int ly = r / I_L; r -= ly * I_L;
            if (r < 2 * I_G) { const int up = r / I_G; r -= up * I_G; const int kb = r / 88, nb = r % 88, n0 = 32 * nb;
                p0_transpose_item((up ? a.ffn_w_up : a.ffn_w_gate) + (size_t)ly * D * DFF, DFF, 64 * kb, n0, WGU + (size_t)ly * 5632 * 1024, 1024, 256 * (n0 / 128) + 128 * up + (n0 % 128), scr, lane); continue; }
            r -= 2 * I_G; { const int kb = r / 32, nb = r % 32; p0_transpose_item(a.ffn_w_down + (size_t)ly * DFF * D, D, 64 * kb, 32 * nb, WDN + (size_t)ly * 1024 * DFF, DFF, 32 * nb, scr, lane); continue; } }
        r -= 2 * I_L;
        { const int g = r / 32, rr = r % 32, kb = rr / 8, nb = rr % 8; p0_transpose_item(a.pool_w + (size_t)g * 65536, 256, 64 * kb, 32 * nb, WPOOL, 256, 256 * g + 32 * nb, scr, lane); }
    }
    __syncthreads();
    bf16_t* XN = (bf16_t*)(ws + WS_R1); float* DT = (float*)(ws + WS_DT);
    f32x4 gv[4];
#pragma unroll
    for (int j = 0; j < 4; ++j) gv[j] = *(const f32x4*)(a.norm_g + 4 * lane + 256 * j);
    for (int m = gw; m < M; m += NGW) {
        const f32x4* xr = (const f32x4*)(a.x + (size_t)m * D) + lane;
        f32x4 v[4]; float s = 0.f;
#pragma unroll
        for (int j = 0; j < 4; ++j) { v[j] = xr[64 * j]; s += (v[j].x * v[j].x + v[j].y * v[j].y) + (v[j].z * v[j].z + v[j].w * v[j].w); }
        const float rstd = rsqrtf(wave_sum(s) * (1.f / D) + EPS);
        unsigned long long* o8 = (unsigned long long*)(XN + (size_t)m * D) + lane;
#pragma unroll
        for (int j = 0; j < 4; ++j) { v[j] = v[j] * rstd * gv[j]; o8[64 * j] = (unsigned long long)pk2(v[j].x, v[j].y) | ((unsigned long long)pk2(v[j].z, v[j].w) << 32); }
        float mine = 0.f;
#pragma unroll 2
        for (int o = 0; o < 16; ++o) { float p = 0.f;
#pragma unroll
            for (int j = 0; j < 4; ++j) { const f32x4 w = *(const LAS f32x4*)(WDT + o * 1024 + 256 * j + 4 * lane); p += (v[j].x * w.x + v[j].y * w.y) + (v[j].z * w.z + v[j].w * w.w); }
            p = wave_sum(p); if (lane == o) mine = p; }
        if (lane < 16) { const float xx = mine + a.dt_bias[lane]; DT[(size_t)m * 16 + lane] = fmaxf(xx, 0.f) + log1pf(expf(-fabsf(xx))); }
    }
    __syncthreads();
}

__device__ __forceinline__ void ssd_dt_acum(LAS float* ACUM, LAS float* DTL, const float* DT, const float* a_log, int c, int g, int wave, int lane) {
    if (wave < 4) {
        const int h = wave; const float av = -expf(a_log[4 * g + h]);
        const float d0 = DT[(size_t)(c * 128 + 2 * lane) * 16 + 4 * g + h], d1 = DT[(size_t)(c * 128 + 2 * lane + 1) * 16 + 4 * g + h];
        const float v0 = d0 * av, v1 = d1 * av; float s = v0 + v1;
#pragma unroll
        for (int o = 1; o < 64; o <<= 1) { const float t = __shfl_up(s, o); if (lane >= o) s += t; }
        ACUM[h * 128 + 2 * lane] = s - v1; ACUM[h * 128 + 2 * lane + 1] = s;
        DTL[h * 128 + 2 * lane] = d0; DTL[h * 128 + 2 * lane + 1] = d1;
    }
}
__device__ __forceinline__ void conv8(const bf16_t* proj, int tg0, int col, const float (&w)[4][8], const float (&b)[8], float (&o)[8][8]) {
    u32x4 raw[11];
#pragma unroll
    for (int i = 0; i < 11; ++i) { const int t = tg0 - 3 + i; raw[i] = (t >= 0) ? *(const u32x4*)(proj + (size_t)t * LDPROJ + col) : (u32x4){0u, 0u, 0u, 0u}; }
#pragma unroll
    for (int i = 0; i < 8; ++i)
#pragma unroll
        for (int j = 0; j < 8; ++j) { float acc = b[j];
#pragma unroll
            for (int k = 0; k < 4; ++k) { const unsigned wd = raw[i + k][j >> 1]; acc += w[k][j] * ((j & 1) ? bfhi(wd) : bflo(wd)); }
            o[i][j] = fsilu(acc); }
}
__device__ __forceinline__ void load_conv_w(const float* conv_w, const float* conv_b, int ch, float (&w)[4][8], float (&b)[8]) {
#pragma unroll
    for (int k = 0; k < 4; ++k) { const f32x4 a0 = *(const f32x4*)(conv_w + k * 2048 + ch), a1 = *(const f32x4*)(conv_w + k * 2048 + ch + 4);
#pragma unroll
        for (int e = 0; e < 4; ++e) { w[k][e] = a0[e]; w[k][4 + e] = a1[e]; } }
    const f32x4 b0 = *(const f32x4*)(conv_b + ch), b1 = *(const f32x4*)(conv_b + ch + 4);
#pragma unroll
    for (int e = 0; e < 4; ++e) { b[e] = b0[e]; b[4 + e] = b1[e]; }
}
constexpr int LROW = 272;

__device__ __forceinline__ void ssd_states_unit(const Args& a, LAS unsigned char* L, int c, int g, int tid, int wave, int lane) {
    LAS unsigned char* XT = L; LAS unsigned char* BT = L + 69632;
    LAS float* ACUM = (LAS float*)(L + 104448); LAS float* DTL = ACUM + 512;
    const bf16_t* proj = (const bf16_t*)(a.ws + WS_PROJ); const float* DT = (const float*)(a.ws + WS_DT); float* CD = (float*)(a.ws + WS_CD);
    ssd_dt_acum(ACUM, DTL, DT, a.a_log, c, g, wave, lane);
    __syncthreads();
    if (tid < 4) CD[c * 16 + 4 * g + tid] = expf(ACUM[tid * 128 + 127]);
    if (tid < 384) {
        const int oct = tid % 48, tr = tid / 48; const bool isx = oct < 32;
        const int ch = isx ? (256 * g + 8 * oct) : (1024 + 128 * g + 8 * (oct - 32));
        float w[4][8], b[8]; load_conv_w(a.conv_w, a.conv_b, ch, w, b);
        const int h = oct >> 3;
#pragma unroll
        for (int half = 0; half < 2; ++half) {
            float o[8][8]; const int l0 = 16 * tr + 8 * half;
            conv8(proj, c * 128 + l0, COL_XBC + ch, w, b, o);
            if (isx) { const float atot = ACUM[h * 128 + 127];
#pragma unroll
                for (int i = 0; i < 8; ++i) { const float sc = DTL[h * 128 + l0 + i] * __expf(atot - ACUM[h * 128 + l0 + i]);
#pragma unroll
                    for (int j = 0; j < 8; ++j) o[i][j] *= sc; } }
            LAS unsigned char* base = isx ? (XT + (8 * oct) * LROW) : (BT + (8 * (oct - 32)) * LROW);
#pragma unroll
            for (int j = 0; j < 8; ++j) { u32x4 p; p.x = pk2(o[0][j], o[1][j]); p.y = pk2(o[2][j], o[3][j]); p.z = pk2(o[4][j], o[5][j]); p.w = pk2(o[6][j], o[7][j]);
                *(LAS u32x4*)(base + j * LROW + l0 * 2) = p; }
        }
    }
    __syncthreads();
    const int r16 = lane & 15, q = lane >> 4;
    f32x4 acc[2][8];
#pragma unroll
    for (int mi = 0; mi < 2; ++mi)
#pragma unroll
        for (int nt = 0; nt < 8; ++nt) acc[mi][nt] = (f32x4){0.f, 0.f, 0.f, 0.f};
#pragma unroll
    for (int ks = 0; ks < 4; ++ks) {
        bf16x8 P[2];
#pragma unroll
        for (int mi = 0; mi < 2; ++mi) P[mi] = *(const LAS bf16x8*)(XT + (32 * wave + 16 * mi + r16) * LROW + (32 * ks + 8 * q) * 2);
#pragma unroll
        for (int nt = 0; nt < 8; ++nt) { const bf16x8 Q = *(const LAS bf16x8*)(BT + (16 * nt + r16) * LROW + (32 * ks + 8 * q) * 2);
#pragma unroll
            for (int mi = 0; mi < 2; ++mi) acc[mi][nt] = MFMA16(Q, P[mi], acc[mi][nt]); }
    }
    bf16_t* ST = (bf16_t*)(a.ws + WS_R1) + ((size_t)(c * 4 + g) * 256) * 128;
#pragma unroll
    for (int mi = 0; mi < 2; ++mi)
#pragma unroll
        for (int nt = 0; nt < 8; ++nt) { u32x2 p; p.x = pk2(acc[mi][nt][0], acc[mi][nt][1]); p.y = pk2(acc[mi][nt][2], acc[mi][nt][3]);
            *(u32x2*)(ST + (size_t)(32 * wave + 16 * mi + r16) * 128 + 16 * nt + 4 * q) = p; }
    __syncthreads();
}

__device__ __forceinline__ void gmlp_unit(const Args& a, LAS unsigned char* L, int c, int h, int tid, int wave, int lane) {
    LAS unsigned char* VT = L; LAS float* MEAN = (LAS float*)(L + 69632); LAS float* RSTD = MEAN + 128;
    bf16_t* proj = (bf16_t*)(a.ws + WS_PROJ);
#pragma unroll
    for (int ib = 0; ib < 2; ++ib) {
        u32x4 r0[8], r1[8];
#pragma unroll
        for (int i = 0; i < 8; ++i) { const bf16_t* row = proj + (size_t)(c * 128 + 16 * wave + 8 * ib + i) * LDPROJ + COL_V; r0[i] = *(const u32x4*)(row + 8 * lane); r1[i] = *(const u32x4*)(row + 512 + 8 * lane); }
#pragma unroll
        for (int i = 0; i < 8; ++i) {
            const int l = 16 * wave + 8 * ib + i;
            float xv[16];
#pragma unroll
            for (int e = 0; e < 4; ++e) { xv[2 * e] = bflo(r0[i][e]); xv[2 * e + 1] = bfhi(r0[i][e]); xv[8 + 2 * e] = bflo(r1[i][e]); xv[8 + 2 * e + 1] = bfhi(r1[i][e]); }
            float s = 0.f;
#pragma unroll
            for (int e = 0; e < 16; ++e) s += xv[e];
            const float mean = wave_sum(s) * (1.f / 1024.f); float qv = 0.f;
#pragma unroll
            for (int e = 0; e < 16; ++e) { const float d = xv[e] - mean; qv += d * d; }
            qv = wave_sum(qv);
            if (lane == 0) { MEAN[l] = mean; RSTD[l] = rsqrtf(qv * (1.f / 1024.f) + EPS); }
        }
    }
    __syncthreads();
    {
        const int oct = tid & 31, tg = tid >> 5; const int chn = 256 * h + 8 * oct;
        float gg[8], bb[8];
        { const f32x4 g0 = *(const f32x4*)(a.gm_ln_g + chn), g1 = *(const f32x4*)(a.gm_ln_g + chn + 4), b0 = *(const f32x4*)(a.gm_ln_b + chn), b1 = *(const f32x4*)(a.gm_ln_b + chn + 4);
#pragma unroll
          for (int e = 0; e < 4; ++e) { gg[e] = g0[e]; gg[4 + e] = g1[e]; bb[e] = b0[e]; bb[4 + e] = b1[e]; } }
        float o[8][8];
#pragma unroll
        for (int i = 0; i < 8; ++i) { const int s = 8 * tg + i; const u32x4 raw = *(const u32x4*)(proj + (size_t)(c * 128 + s) * LDPROJ + COL_V + chn);
            const float mu = MEAN[s], rs = RSTD[s];
#pragma unroll
            for (int e = 0; e < 4; ++e) { o[i][2 * e] = (bflo(raw[e]) - mu) * rs * gg[2 * e] + bb[2 * e]; o[i][2 * e + 1] = (bfhi(raw[e]) - mu) * rs * gg[2 * e + 1] + bb[2 * e + 1]; } }
#pragma unroll
        for (int j = 0; j < 8; ++j) { u32x4 p; p.x = pk2(o[0][j], o[1][j]); p.y = pk2(o[2][j], o[3][j]); p.z = pk2(o[4][j], o[5][j]); p.w = pk2(o[6][j], o[7][j]);
            *(LAS u32x4*)(VT + (8 * oct + j) * LROW + (8 * tg) * 2) = p; }
    }
    __syncthreads();
    const int r16 = lane & 15, q = lane >> 4, t = 16 * wave + r16;
    f32x4 acc[16];
#pragma unroll
    for (int d = 0; d < 16; ++d) acc[d] = (f32x4){0.f, 0.f, 0.f, 0.f};
#pragma unroll
    for (int ks = 0; ks < 4; ++ks) if (2 * ks <= wave) {
        const float* wrow = a.gm_ws + ((size_t)h * 128 + t) * 128 + 32 * ks + 8 * q;
        const f32x4 f0 = *(const f32x4*)wrow, f1 = *(const f32x4*)(wrow + 4);
        float wv[8];
#pragma unroll
        for (int e = 0; e < 4; ++e) { wv[e] = f0[e]; wv[4 + e] = f1[e]; }
#pragma unroll
        for (int e = 0; e < 8; ++e) wv[e] = (32 * ks + 8 * q + e <= t) ? wv[e] : 0.f;
        u32x4 pw; pw.x = pk2(wv[0], wv[1]); pw.y = pk2(wv[2], wv[3]); pw.z = pk2(wv[4], wv[5]); pw.w = pk2(wv[6], wv[7]);
        const bf16x8 P = __builtin_bit_cast(bf16x8, pw);
#pragma unroll
        for (int d = 0; d < 16; ++d) { const bf16x8 Q = *(const LAS bf16x8*)(VT + (16 * d + r16) * LROW + (32 * ks + 8 * q) * 2); acc[d] = MFMA16(Q, P, acc[d]); }
    }
    const float bs = a.gm_bs[h * 128 + t];
    bf16_t* urow = proj + (size_t)(c * 128 + t) * LDPROJ + COL_U + 256 * h + 4 * q;
#pragma unroll
    for (int d = 0; d < 16; ++d) { const u32x2 uu = *(const u32x2*)(urow + 16 * d);
        u32x2 p; p.x = pk2((acc[d][0] + bs) * bflo(uu.x), (acc[d][1] + bs) * bfhi(uu.x)); p.y = pk2((acc[d][2] + bs) * bflo(uu.y), (acc[d][3] + bs) * bfhi(uu.y));
        *(u32x2*)(urow + 16 * d) = p; }
    __syncthreads();
}

__device__ __forceinline__ void ssd_scan(const Args& a, int tid) {
    bf16_t* ST = (bf16_t*)(a.ws + WS_R1); const float* CD = (const float*)(a.ws + WS_CD);
    for (int e = blockIdx.x * 512 + tid; e < 131072; e += gridDim.x * 512) {
        const int hh = e >> 13; float st = 0.f;
        for (int c0 = 0; c0 < NCHUNK; c0 += 16) {
            float nw[16], cd[16];
#pragma unroll
            for (int i = 0; i < 16; ++i) { nw[i] = __uint_as_float((unsigned)ST[(size_t)(c0 + i) * 131072 + e] << 16); cd[i] = CD[(c0 + i) * 16 + hh]; }
#pragma unroll
            for (int i = 0; i < 16; ++i) { ST[(size_t)(c0 + i) * 131072 + e] = (bf16_t)(pk2(st, 0.f) & 0xffffu); st = st * cd[i] + nw[i]; }
        }
    }
}

__device__ __forceinline__ void ssd_out_unit(const Args& a, LAS unsigned char* L, int c, int g, int tid, int wave, int lane) {
    LAS unsigned char* CL = L; LAS unsigned char* BL = L + 34816; LAS unsigned char* XT = L + 69632;
    LAS float* ACUM = (LAS float*)(L + 139264); LAS float* DTL = ACUM + 512;
    bf16_t* proj = (bf16_t*)(a.ws + WS_PROJ); const float* DT = (const float*)(a.ws + WS_DT);
    ssd_dt_acum(ACUM, DTL, DT, a.a_log, c, g, wave, lane);
    {
        const int oct = tid & 63, tr = tid >> 6;
        const int ch = oct < 32 ? (256 * g + 8 * oct) : (oct < 48 ? (1024 + 128 * g + 8 * (oct - 32)) : (1536 + 128 * g + 8 * (oct - 48)));
        float w[4][8], b[8]; load_conv_w(a.conv_w, a.conv_b, ch, w, b);
#pragma unroll
        for (int half = 0; half < 2; ++half) {
            float o[8][8]; const int l0 = 16 * tr + 8 * half;
            conv8(proj, c * 128 + l0, COL_XBC + ch, w, b, o);
            if (oct < 32) {
#pragma unroll
                for (int j = 0; j < 8; ++j) { u32x4 p; p.x = pk2(o[0][j], o[1][j]); p.y = pk2(o[2][j], o[3][j]); p.z = pk2(o[4][j], o[5][j]); p.w = pk2(o[6][j], o[7][j]);
                    *(LAS u32x4*)(XT + (8 * oct + j) * LROW + l0 * 2) = p; }
            } else {
                LAS unsigned char* base = (oct < 48 ? BL : CL) + (8 * ((oct - 32) & 15)) * 2;
#pragma unroll
                for (int i = 0; i < 8; ++i) { u32x4 p; p.x = pk2(o[i][0], o[i][1]); p.y = pk2(o[i][2], o[i][3]); p.z = pk2(o[i][4], o[i][5]); p.w = pk2(o[i][6], o[i][7]);
                    *(LAS u32x4*)(base + (l0 + i) * LROW) = p; }
            }
        }
    }
    __syncthreads();
    const int r16 = lane & 15, q = lane >> 4, l = 16 * wave + r16;
    f32x4 cb[8];
#pragma unroll
    for (int t = 0; t < 8; ++t) cb[t] = (f32x4){0.f, 0.f, 0.f, 0.f};
    bf16x8 PC[4];
#pragma unroll
    for (int ks = 0; ks < 4; ++ks) PC[ks] = *(const LAS bf16x8*)(CL + l * LROW + (32 * ks + 8 * q) * 2);
#pragma unroll
    for (int ks = 0; ks < 4; ++ks)
#pragma unroll
        for (int t = 0; t < 8; ++t) if (t <= wave) { const bf16x8 Q = *(const LAS bf16x8*)(BL + (16 * t + r16) * LROW + (32 * ks + 8 * q) * 2); cb[t] = MFMA16(Q, PC[ks], cb[t]); }
    float gated[4][4][4]; float ssq = 0.f;
    const bf16_t* STg = (const bf16_t*)(a.ws + WS_R1) + ((size_t)(c * 4 + g) * 256) * 128;
    const size_t rowoff = (size_t)(c * 128 + l) * LDPROJ + COL_Z + 256 * g + 4 * q;
#pragma unroll
    for (int h = 0; h < 4; ++h) {
        const float al = ACUM[h * 128 + l], Dh = a.d_skip[4 * g + h];
        bf16x8 pf[4];
#pragma unroll
        for (int ks = 0; ks < 4; ++ks) {
            u32x4 wd = (u32x4){0u, 0u, 0u, 0u};
#pragma unroll
            for (int h2 = 0; h2 < 2; ++h2) { const int t = 2 * ks + h2;
                if (t <= wave) {
                    const f32x4 as4 = *(const LAS f32x4*)(ACUM + h * 128 + 16 * t + 4 * q), dt4 = *(const LAS f32x4*)(DTL + h * 128 + 16 * t + 4 * q);
                    float v[4];
#pragma unroll
                    for (int r = 0; r < 4; ++r) { const int s = 16 * t + 4 * q + r; v[r] = (s <= l) ? cb[t][r] * __expf(al - as4[r]) * dt4[r] : 0.f; if (s == l) v[r] += Dh; }
                    wd[2 * h2] = pk2(v[0], v[1]); wd[2 * h2 + 1] = pk2(v[2], v[3]);
                } }
            pf[ks] = __builtin_bit_cast(bf16x8, wd);
        }
        f32x4 acc[4];
#pragma unroll
        for (int pt = 0; pt < 4; ++pt) acc[pt] = (f32x4){0.f, 0.f, 0.f, 0.f};
        const bf16_t* STh = STg + (size_t)(64 * h) * 128;
#pragma unroll
        for (int ks = 0; ks < 4; ++ks)
#pragma unroll
            for (int pt = 0; pt < 4; ++pt) { const bf16x8 Q = *(const bf16x8*)(STh + (size_t)(16 * pt + r16) * 128 + 32 * ks + 8 * q); acc[pt] = MFMA16(Q, PC[ks], acc[pt]); }
        const float ea = __expf(al);
#pragma unroll
        for (int pt = 0; pt < 4; ++pt) acc[pt] = acc[pt] * ea;
#pragma unroll
        for (int ks = 0; ks < 4; ++ks) if (2 * ks <= wave) {
#pragma unroll
            for (int pt = 0; pt < 4; ++pt) { const LAS unsigned char* xr = XT + (64 * h + 16 * pt + r16) * LROW + (32 * ks + 4 * q) * 2;
                const s16x4 lo = *(const LAS s16x4*)xr, hi = *(const LAS s16x4*)(xr + 32);
                const bf16x8 Q = __builtin_shufflevector(lo, hi, 0, 1, 2, 3, 4, 5, 6, 7);
                acc[pt] = MFMA16(Q, pf[ks], acc[pt]); }
        }
#pragma unroll
        for (int pt = 0; pt < 4; ++pt) { const u32x2 zz = *(const u32x2*)(proj + rowoff + 64 * h + 16 * pt);
            const float z0 = bflo(zz.x), z1 = bfhi(zz.x), z2 = bflo(zz.y), z3 = bfhi(zz.y);
            const float g0 = acc[pt][0] * fsilu(z0), g1 = acc[pt][1] * fsilu(z1), g2 = acc[pt][2] * fsilu(z2), g3 = acc[pt][3] * fsilu(z3);
            gated[h][pt][0] = g0; gated[h][pt][1] = g1; gated[h][pt][2] = g2; gated[h][pt][3] = g3; ssq += (g0 * g0 + g1 * g1) + (g2 * g2 + g3 * g3); }
    }
    ssq += __shfl_xor(ssq, 16); ssq += __shfl_xor(ssq, 32);
    const float rstd = rsqrtf(ssq * (1.f / 256.f) + EPS);
#pragma unroll
    for (int h = 0; h < 4; ++h)
#pragma unroll
        for (int pt = 0; pt < 4; ++pt) { const f32x4 ng = *(const f32x4*)(a.ssm_norm_g + 256 * g + 64 * h + 16 * pt + 4 * q);
            u32x2 p; p.x = pk2(gated[h][pt][0] * rstd * ng[0], gated[h][pt][1] * rstd * ng[1]); p.y = pk2(gated[h][pt][2] * rstd * ng[2], gated[h][pt][3] * rstd * ng[3]);
            *(u32x2*)(proj + rowoff + 64 * h + 16 * pt) = p; }
    __syncthreads();
}

__device__ __forceinline__ void norm_pass(const bf16_t* Y, const float* hin, float* hout, bf16_t* xn, const float* g1, const float* g2, int wave, int lane) {
    const int gw = blockIdx.x * 8 + wave, NGW = gridDim.x * 8;
    f32x4 g1v[4], g2v[4];
#pragma unroll
    for (int j = 0; j < 4; ++j) { g1v[j] = *(const f32x4*)(g1 + 4 * lane + 256 * j); g2v[j] = xn ? *(const f32x4*)(g2 + 4 * lane + 256 * j) : (f32x4){0.f, 0.f, 0.f, 0.f}; }
    for (int m = gw; m < M; m += NGW) {
        const u32x2* yr = (const u32x2*)(Y + (size_t)m * D) + lane; const f32x4* hr = (const f32x4*)(hin + (size_t)m * D) + lane;
        f32x4 y[4], hv[4]; float s = 0.f;
#pragma unroll
        for (int j = 0; j < 4; ++j) { const u32x2 w = yr[64 * j]; hv[j] = hr[64 * j]; y[j] = (f32x4){bflo(w.x), bfhi(w.x), bflo(w.y), bfhi(w.y)};
            s += (y[j].x * y[j].x + y[j].y * y[j].y) + (y[j].z * y[j].z + y[j].w * y[j].w); }
        const float rs = rsqrtf(wave_sum(s) * (1.f / D) + EPS); float s2 = 0.f;
#pragma unroll
        for (int j = 0; j < 4; ++j) { hv[j] = hv[j] + y[j] * rs * g1v[j]; s2 += (hv[j].x * hv[j].x + hv[j].y * hv[j].y) + (hv[j].z * hv[j].z + hv[j].w * hv[j].w); }
        f32x4* ho = (f32x4*)(hout + (size_t)m * D) + lane;
#pragma unroll
        for (int j = 0; j < 4; ++j) ho[64 * j] = hv[j];
        if (xn) {
            const float rs2 = rsqrtf(wave_sum(s2) * (1.f / D) + EPS);
            unsigned long long* o8 = (unsigned long long*)(xn + (size_t)m * D) + lane;
#pragma unroll
            for (int j = 0; j < 4; ++j) { const f32x4 v = hv[j] * rs2 * g2v[j]; o8[64 * j] = (unsigned long long)pk2(v.x, v.y) | ((unsigned long long)pk2(v.z, v.w) << 32); }
        }
    }
}

__device__ __forceinline__ void pool_pass(const bf16_t* xn, bf16_t* dp, int tid) {
    const int win = 2 << (tid >> 7);
    for (int u = blockIdx.x; u < M / 32; u += gridDim.x) {
        const int t0 = 32 * u; const unsigned* base = (const unsigned*)xn + tid;
        float s0 = 0.f, s1 = 0.f;
        for (int j = 1; j < win; ++j) { const int tt = t0 - j; if (tt >= 0) { const unsigned w = base[(size_t)tt * 512]; s0 += bflo(w); s1 += bfhi(w); } }
#pragma unroll 4
        for (int i = 0; i < 32; ++i) { const int t = t0 + i; const unsigned w = base[(size_t)t * 512]; const float c0 = bflo(w), c1 = bfhi(w);
            s0 += c0; s1 += c1; const float inv = 1.f / (float)((t + 1 < win) ? (t + 1) : win);
            ((unsigned*)dp)[(size_t)t * 512 + tid] = pk2(s0 * inv - c0, s1 * inv - c1);
            const int old = t - win + 1; if (old >= 0) { const unsigned wo = base[(size_t)old * 512]; s0 -= bflo(wo); s1 -= bfhi(wo); } }
    }
}

__global__ void __launch_bounds__(512, 2) fwd_kernel(Args a) {
    extern __shared__ __attribute__((aligned(16))) unsigned char lds_raw[];
    LAS unsigned char* L = (LAS unsigned char*)lds_raw;
    const int tid = threadIdx.x, lane = tid & 63, wave = __builtin_amdgcn_readfirstlane(tid >> 6);
    const int lo = a.ph_lo, hi = a.ph_hi, G = gridDim.x;
    unsigned char* ws = a.ws;
    bf16_t* WIN = (bf16_t*)(ws + WS_WIN); bf16_t* WOUT = (bf16_t*)(ws + WS_WOUT); bf16_t* WGU = (bf16_t*)(ws + WS_WGU); bf16_t* WDN = (bf16_t*)(ws + WS_WDN); bf16_t* WPOOL = (bf16_t*)(ws + WS_WPOOL);
    bf16_t* R1 = (bf16_t*)(ws + WS_R1); bf16_t* PROJ = (bf16_t*)(ws + WS_PROJ);
    bf16_t* XN2 = PROJ;
    bf16_t* HID = (bf16_t*)(ws + WS_PROJ + 32 * MiB);
#ifndef PHMASK
#define PHMASK 0xffff
#endif
#ifndef REPMASK
#define REPMASK 0x0
#endif
#define IN(k) (((PHMASK >> (k)) & 1) && lo <= (k) && (k) < hi)
#define REP(k) for (int rep_ = 0; rep_ < 1 + ((REPMASK >> (k)) & 1); ++rep_)
#if ONE_LAUNCH
    volatile LAS unsigned* bst = (volatile LAS unsigned*)(L + LDS_BYTES - 64);
    if (tid == 0) { bst[0] = 0u; bst[1] = 0u; }
    __syncthreads();
    const XcdBarrier xbar = xcd_barrier_post((unsigned*)ws, bst);
#define SEAM(k) do { if (IN(k) && IN((k) + 1)) { if ((k) == 0) cg::this_grid().sync(); else xcd_barrier(xbar); } } while (0)
#else
#define SEAM(k) do { } while (0)
#endif
    if (IN(0)) REP(0) { p0_prologue(a, L, tid, wave, lane); } SEAM(0);
    if (IN(1)) { pg8::Gemm g{R1, WIN, M, 5120, 1024, 1024, 1024, 0}; pg8::StaticOrder S; S.init(M, 5120, G, blockIdx.x, (REPMASK >> 1) & 1); pg8::EpiProj E{PROJ, LDPROJ}; pg8::gemm_phase(L, g, S, E); } SEAM(1);
    if (IN(2)) { for (int u = blockIdx.x; u < 1024; u += G) { const int k = u & 511; if (u < 512) ssd_states_unit(a, L, k >> 2, k & 3, tid, wave, lane); else gmlp_unit(a, L, k >> 2, k & 3, tid, wave, lane); } } SEAM(2);
    if (IN(3)) { ssd_scan(a, tid); } SEAM(3);
    if (IN(4)) { for (int u = blockIdx.x; u < 512; u += G) ssd_out_unit(a, L, u >> 2, u & 3, tid, wave, lane); } SEAM(4);
    if (IN(5)) { pg8::Gemm g{PROJ, WOUT, M, 1024, 2048, LDPROJ, 2048, 0}; pg8::StaticOrder S; S.init(M, 1024, G, blockIdx.x, (REPMASK >> 5) & 1); pg8::EpiY E{R1, 1024, nullptr, nullptr}; pg8::gemm_phase(L, g, S, E); } SEAM(5);
    if (IN(6)) REP(6) { norm_pass(R1, a.x, a.out, XN2, a.norm_g + 1 * D, a.norm_g + 2 * D, wave, lane); } SEAM(6);
    if (IN(7)) { pg8::Gemm g{XN2, WGU, M, 5632, 1024, 1024, 1024, 0}; pg8::StaticOrder S; S.init(M, 5632, G, blockIdx.x, (REPMASK >> 7) & 1); pg8::EpiSwiGLU E{HID, DFF}; pg8::gemm_phase(L, g, S, E); } SEAM(7);
    if (IN(8)) { pg8::Gemm g{HID, WDN, M, 1024, DFF, DFF, DFF, 0}; pg8::StaticOrder S; S.init(M, 1024, G, blockIdx.x, (REPMASK >> 8) & 1); pg8::EpiY E{R1, 1024, nullptr, nullptr}; pg8::gemm_phase(L, g, S, E); } SEAM(8);
    if (IN(9)) { norm_pass(R1, a.out, a.out, XN2, a.norm_g + 3 * D, a.norm_g + 4 * D, wave, lane); } SEAM(9);
    if (IN(10)) REP(10) { pool_pass(XN2, HID, tid); } SEAM(10);
    if (IN(11)) { pg8::Gemm g{HID, WPOOL, M, 1024, 256, 1024, 256, 512}; pg8::StaticOrder S; S.init(M, 1024, G, blockIdx.x, (REPMASK >> 11) & 1); pg8::EpiY E{R1, 1024, a.pool_b, a.pool_scale}; pg8::gemm_phase(L, g, S, E); } SEAM(11);
    if (IN(12)) { norm_pass(R1, a.out, a.out, XN2, a.norm_g + 5 * D, a.norm_g + 6 * D, wave, lane); } SEAM(12);
    if (IN(13)) { pg8::Gemm g{XN2, WGU + (size_t)5632 * 1024, M, 5632, 1024, 1024, 1024, 0}; pg8::StaticOrder S; S.init(M, 5632, G, blockIdx.x, (REPMASK >> 13) & 1); pg8::EpiSwiGLU E{HID, DFF}; pg8::gemm_phase(L, g, S, E); } SEAM(13);
    if (IN(14)) { pg8::Gemm g{HID, WDN + (size_t)1024 * DFF, M, 1024, DFF, DFF, DFF, 0}; pg8::StaticOrder S; S.init(M, 1024, G, blockIdx.x, (REPMASK >> 14) & 1); pg8::EpiY E{R1, 1024, nullptr, nullptr}; pg8::gemm_phase(L, g, S, E); } SEAM(14);
    if (IN(15)) { norm_pass(R1, a.out, a.out, nullptr, a.norm_g + 7 * D, nullptr, wave, lane); }
#undef IN
#undef SEAM
}

extern "C" void kernel_launch(void* const* d_in, const int* in_sizes, int n_in, void* d_out, int out_size, void* d_ws, size_t ws_size, hipStream_t stream) {
    static int grid = 0;
    if (grid == 0) {
        if (n_in != 20 || out_size != M * D || ws_size < WS_END) { fprintf(stderr, "kernel_launch: unexpected shapes (n_in %d out %d ws %zu)\n", n_in, out_size, ws_size); grid = -1; return; }
        int dev = 0, cus = 0, per_cu = 0;
        (void)hipGetDevice(&dev); (void)hipDeviceGetAttribute(&cus, hipDeviceAttributeMultiprocessorCount, dev);
        if (hipFuncSetAttribute((const void*)fwd_kernel, hipFuncAttributeMaxDynamicSharedMemorySize, LDS_BYTES) != hipSuccess) { fprintf(stderr, "kernel_launch: hipFuncSetAttribute failed\n"); }
        (void)hipOccupancyMaxActiveBlocksPerMultiprocessor(&per_cu, (const void*)fwd_kernel, 512, LDS_BYTES);
        (void)hipGetLastError();
        if (per_cu < 1) { fprintf(stderr, "kernel_launch: occupancy query says %d blocks per CU\n", per_cu); per_cu = 1; }
        grid = cus;
        fprintf(stderr, "kernel_launch: grid %d (per_cu %d)\n", grid, per_cu);
    }
    if (grid < 0) return;
    Args a{};
    const float** ap = (const float**)&a;
    for (int i = 0; i < 20; ++i) ap[i] = (const float*)d_in[i];
    a.out = (float*)d_out; a.ws = (unsigned char*)d_ws;
#if ONE_LAUNCH
    a.ph_lo = 0; a.ph_hi = NPHASE;
    if (hipMemsetAsync(d_ws, 0, 16384, stream) != hipSuccess) { fprintf(stderr, "kernel_launch: memset of the barrier words failed\n"); return; }
    void* args[] = {&a};
    hipError_t e = hipLaunchCooperativeKernel((const void*)fwd_kernel, dim3(grid), dim3(512), args, LDS_BYTES, stream);
    if (e != hipSuccess) fprintf(stderr, "cooperative launch failed: %s (grid %d)\n", hipGetErrorString(e), grid);
#else
    for (int p = 0; p < NPHASE; ++p) { a.ph_lo = p; a.ph_hi = p + 1; hipLaunchKernelGGL(fwd_kernel, dim3(grid), dim3(512), LDS_BYTES, stream, a); }
#endif
}
```
